# Optimizing an MI355X kernel written in HIP

```python
import math
import jax, jax.numpy as jnp
from jax import lax
import numpy as np

D_MODEL = 1024
BATCH = 2
SEQ = 16384
DEPTH = 4

N_MEM = 256
GLA_HEADS = 4
GLA_DK = D_MODEL // 16
GLA_DV = D_MODEL // 8
GLA_RANK = 16
GLA_GATE_NORM = 16.0
GLA_CHUNK = 64
SB_HEADS = 4
SB_DH = D_MODEL // 16
SB_BLOCK = 128
SB_GROUPS = 8
MEM_HEADS = 4
MEM_DH = D_MODEL // 16
GLA_QK_W = GLA_HEADS * GLA_DK
GLA_V_W = GLA_HEADS * GLA_DV
SB_W = SB_HEADS * SB_DH
MEM_W = MEM_HEADS * MEM_DH
D_MIX = GLA_V_W + SB_W + MEM_W
SPLIT_NAMES = ("gla_q", "gla_k", "gla_v", "gla_gate", "gla_alpha",
               "sb_q", "sb_k", "sb_v", "sb_gate", "mem_q", "mem_gate")
SPLIT_SIZES = (GLA_QK_W, GLA_QK_W, GLA_V_W, GLA_V_W, GLA_RANK,
               SB_W, SB_W, SB_W, SB_W, MEM_W, MEM_W)
D_IN = 3088
ALPHA = (2.0 * DEPTH) ** 0.25
BETA = (8.0 * DEPTH) ** -0.25
LN_EPS = 1e-5
RMS_EPS = 1e-6

kernel_name = "gla_stickbreaking_memxattn_deepnorm_hybrid"


def _split_cols(proj):
    parts, off = [], 0
    for n in SPLIT_SIZES:
        parts.append(proj[..., off:off + n])
        off += n
    return parts


def _layer_norm(x, g, b):
    xf = x.astype(jnp.float32)
    mu = jnp.mean(xf, axis=-1, keepdims=True)
    var = jnp.mean(jnp.square(xf - mu), axis=-1, keepdims=True)
    return ((xf - mu) * lax.rsqrt(var + LN_EPS) * g + b).astype(x.dtype)


def _gla(q, k, v, log_a):
    B, T, H, dk = q.shape
    dv = v.shape[-1]
    n = T // GLA_CHUNK

    def to_chunks(t):
        return t.astype(jnp.float32).reshape(B, n, GLA_CHUNK, H, t.shape[-1]).transpose(1, 0, 3, 2, 4)

    qc = to_chunks(q) * (dk ** -0.5)
    kc, vc, gc = to_chunks(k), to_chunks(v), to_chunks(log_a)
    causal = jnp.asarray(np.tril(np.ones((GLA_CHUNK, GLA_CHUNK), dtype=bool)))

    def step(S, inp):
        qb, kb, vb, gb = inp
        G = jnp.cumsum(gb, axis=2)
        o_inter = jnp.einsum('bhck,bhkv->bhcv', qb * jnp.exp(G), S)
        diff = G[:, :, :, None, :] - G[:, :, None, :, :]
        decay = jnp.exp(jnp.where(causal[None, None, :, :, None], diff, -jnp.inf))
        A = jnp.einsum('bhik,bhjk,bhijk->bhij', qb, kb, decay)
        o_intra = jnp.einsum('bhij,bhjv->bhiv', A, vb)
        G_last = G[:, :, -1]
        k_dec = kb * jnp.exp(G_last[:, :, None, :] - G)
        S = jnp.exp(G_last)[..., None] * S + jnp.einsum('bhck,bhcv->bhkv', k_dec, vb)
        return S, o_inter + o_intra

    S0 = jnp.zeros((B, H, dk, dv), jnp.float32)
    _, o = lax.scan(step, S0, (qc, kc, vc, gc))
    return o.transpose(1, 0, 3, 2, 4).reshape(B, T, H, dv)


def _stick_breaking(q, k, v):
    B, T, H, d = q.shape
    nq = T // SB_BLOCK
    n_groups = math.gcd(nq, SB_GROUPS)
    gs = nq // n_groups
    qf = (q.astype(jnp.float32) * (d ** -0.5)).transpose(0, 2, 1, 3)
    kt = k.astype(jnp.float32).transpose(0, 2, 1, 3)
    vt = v.astype(jnp.float32).transpose(0, 2, 1, 3)
    tri_in = jnp.asarray(np.tril(np.ones((SB_BLOCK, SB_BLOCK), np.float32), -1))
    outs = []
    for g in range(n_groups):
        nb = (g + 1) * gs
        L = nb * SB_BLOCK
        k_g, v_g = kt[:, :, :L], vt[:, :, :L]
        tri_blk = jnp.asarray(np.tril(np.ones((nb, nb), np.float32), -1))
        key_pos = jnp.arange(L)
        q_g = qf[:, :, g * gs * SB_BLOCK:(g + 1) * gs * SB_BLOCK].reshape(
            B, H, gs, SB_BLOCK, d).transpose(2, 0, 1, 3, 4)
        starts = (g * gs + jnp.arange(gs, dtype=jnp.int32)) * SB_BLOCK

        def block(args, k_g=k_g, v_g=v_g, tri_blk=tri_blk, key_pos=key_pos, nb=nb, L=L):
            qblk, start = args
            z = jnp.einsum('bhqd,bhkd->bhqk', qblk, k_g)
            q_pos = start + jnp.arange(SB_BLOCK)
            mask = key_pos[None, :] < q_pos[:, None]
            lsn = jax.nn.log_sigmoid(-z)
            lf = jnp.where(mask, lsn, 0.0).reshape(B, H, SB_BLOCK, nb, SB_BLOCK)
            within = jnp.einsum('bhqnk,kj->bhqnj', lf, tri_in)
            across = jnp.einsum('bhqn,nm->bhqm', jnp.sum(lf, axis=-1), tri_blk)
            rest = (within + across[..., None]).reshape(B, H, SB_BLOCK, L)
            w = jnp.exp(jnp.where(mask, z + lsn + rest, -jnp.inf))
            return jnp.einsum('bhqk,bhkd->bhqd', w, v_g)

        o = lax.map(block, (q_g, starts))
        outs.append(o.transpose(1, 2, 0, 3, 4).reshape(B, H, gs * SB_BLOCK, d))
    o = jnp.concatenate(outs, axis=2)
    return o.transpose(0, 2, 1, 3).reshape(B, T, H * d)


def _mem_attn(q, mem, w_mkv):
    B, T, _ = q.shape
    kv = mem @ w_mkv
    km = kv[..., :MEM_W].reshape(B, N_MEM, MEM_HEADS, MEM_DH)
    vm = kv[..., MEM_W:].reshape(B, N_MEM, MEM_HEADS, MEM_DH)
    qh = q.reshape(B, T, MEM_HEADS, MEM_DH)
    s = jnp.einsum('bthd,bmhd->bhtm', qh, km).astype(jnp.float32) * (MEM_DH ** -0.5)
    p = jax.nn.softmax(s, axis=-1)
    o = jnp.einsum('bhtm,bmhd->bthd', p, vm.astype(jnp.float32))
    return o.reshape(B, T, MEM_W)


def _layer(x, mem, w_in, w_a2, b_a, gla_nw, w_mkv, w_out, ln_g, ln_b):
    B, T, _ = x.shape
    proj = x @ w_in
    gq, gk, gv, gg, ga, sq, sk, sv, sg, mq, mg = _split_cols(proj)
    log_a = jax.nn.log_sigmoid((ga @ w_a2 + b_a).astype(jnp.float32)) / GLA_GATE_NORM
    o_gla = _gla(gq.reshape(B, T, GLA_HEADS, GLA_DK), gk.reshape(B, T, GLA_HEADS, GLA_DK),
                 gv.reshape(B, T, GLA_HEADS, GLA_DV), log_a.reshape(B, T, GLA_HEADS, GLA_DK))
    o_gla = o_gla * lax.rsqrt(jnp.mean(jnp.square(o_gla), axis=-1, keepdims=True) + RMS_EPS) * gla_nw
    o_gla = o_gla.reshape(B, T, GLA_V_W)
    o_sb = _stick_breaking(sq.reshape(B, T, SB_HEADS, SB_DH), sk.reshape(B, T, SB_HEADS, SB_DH),
                           sv.reshape(B, T, SB_HEADS, SB_DH))
    o_mem = _mem_attn(mq, mem, w_mkv)
    mix = jnp.concatenate([o_gla * jax.nn.silu(gg.astype(jnp.float32)),
                           o_sb * jax.nn.silu(sg.astype(jnp.float32)),
                           o_mem * jax.nn.silu(mg.astype(jnp.float32))], axis=-1).astype(x.dtype)
    y = mix @ w_out
    return _layer_norm(ALPHA * x + y, ln_g, ln_b)


def setup_inputs(seed: int = 0) -> dict:
    key = jax.random.key(seed)
    ks = jax.random.split(key, 10)
    x = jax.random.normal(ks[0], (BATCH, SEQ, D_MODEL), jnp.float32)
    mem = jax.random.normal(ks[1], (BATCH, N_MEM, D_MODEL), jnp.float32)
    col_scale = np.full((D_IN,), D_MODEL ** -0.5, np.float32)
    off = 0
    for name, n in zip(SPLIT_NAMES, SPLIT_SIZES):
        if name in ("gla_v", "sb_v"):
            col_scale[off:off + n] *= BETA
        off += n
    w_in = jax.random.normal(ks[2], (DEPTH, D_MODEL, D_IN), jnp.float32) * jnp.asarray(col_scale)
    w_alpha2 = jax.random.normal(ks[3], (DEPTH, GLA_RANK, GLA_QK_W), jnp.float32) * GLA_RANK ** -0.5
    b_alpha = 0.1 * jax.random.normal(ks[4], (DEPTH, GLA_QK_W), jnp.float32)
    gla_norm_w = 1.0 + 0.02 * jax.random.normal(ks[5], (DEPTH, GLA_DV), jnp.float32)
    mkv_scale = np.concatenate([np.full((MEM_W,), D_MODEL ** -0.5, np.float32),
                                np.full((MEM_W,), D_MODEL ** -0.5 * BETA, np.float32)])
    w_mem_kv = jax.random.normal(ks[6], (DEPTH, D_MODEL, 2 * MEM_W), jnp.float32) * jnp.asarray(mkv_scale)
    w_out = jax.random.normal(ks[7], (DEPTH, D_MIX, D_MODEL), jnp.float32) * (D_MIX ** -0.5 * BETA)
    ln_g = 1.0 + 0.02 * jax.random.normal(ks[8], (DEPTH, D_MODEL), jnp.float32)
    ln_b = 0.02 * jax.random.normal(ks[9], (DEPTH, D_MODEL), jnp.float32)
    return {"x": x, "mem": mem, "w_in": w_in, "w_alpha2": w_alpha2, "b_alpha": b_alpha,
            "gla_norm_w": gla_norm_w, "w_mem_kv": w_mem_kv, "w_out": w_out,
            "ln_g": ln_g, "ln_b": ln_b}


def reference(x, mem, w_in, w_alpha2, b_alpha, gla_norm_w, w_mem_kv, w_out, ln_g, ln_b):
    for l in range(DEPTH):
        x = _layer(x, mem, w_in[l], w_alpha2[l], b_alpha[l], gla_norm_w[l], w_mem_kv[l],
                   w_out[l], ln_g[l], ln_b[l])
    return x
```

```cpp
#include <hip/hip_runtime.h>
#include <hip/hip_cooperative_groups.h>
#include <cstdio>
namespace cg = cooperative_groups;

#define DI __device__ __forceinline__
#define LAS __attribute__((address_space(3)))
typedef unsigned short u16;
typedef short bf16x8 __attribute__((ext_vector_type(8)));
typedef short s16x4 __attribute__((ext_vector_type(4)));
typedef float f32x2 __attribute__((ext_vector_type(2)));
typedef float f32x4 __attribute__((ext_vector_type(4)));
typedef float f32x16 __attribute__((ext_vector_type(16)));
typedef unsigned u32x2 __attribute__((ext_vector_type(2)));
typedef unsigned u32x4 __attribute__((ext_vector_type(4)));
typedef __bf16 bf16x2v __attribute__((ext_vector_type(2)));

constexpr int SEQ = 16384, NB = 2, MTOK = NB * SEQ, DM = 1024, DEPTH = 4, NMEM = 256, DIN = 3088;
constexpr int LDN = 2304;
constexpr int PN_GQ = 0, PN_GK = 256, PN_GG = 512, PN_SQ = 1024, PN_SK = 1280, PN_SG = 1536, PN_MQ = 1792, PN_MG = 2048;
constexpr int NBT = 3584;
constexpr int PT_GK = 0, PT_GV = 256, PT_SV = 768;
constexpr float ALPHA_DN = 1.681792830507429f;
constexpr float LN_EPS = 1e-5f, RMS_EPS = 1e-6f;
constexpr float SB_THR = 40.0f;
constexpr int GS = 260;

constexpr size_t WS_BT = 0;
constexpr size_t WS_BO = WS_BT + (size_t)DEPTH * NBT * 1024 * 2;
constexpr size_t WS_KM = WS_BO + (size_t)DEPTH * 1024 * 1024 * 2;
constexpr size_t WS_VMT = WS_KM + (size_t)DEPTH * NB * 4 * 256 * 64 * 2;
constexpr size_t WS_XB = WS_VMT + (size_t)DEPTH * NB * 4 * 256 * 64 * 2;
constexpr size_t WS_PN = WS_XB + (size_t)MTOK * 1024 * 2;
constexpr size_t WS_LA = WS_PN + (size_t)MTOK * LDN * 2;
constexpr size_t WS_PT = WS_LA + (size_t)MTOK * 256 * 4;
constexpr size_t WS_MIX = WS_PT + (size_t)1024 * MTOK * 2;
constexpr size_t WS_U = WS_MIX + (size_t)MTOK * 1024 * 2;
constexpr size_t WS_GD = WS_U + (size_t)512 * 4 * 128 * 64 * 4;
constexpr size_t WS_END = WS_GD + (size_t)512 * 4 * 64 * 4;
constexpr int LDS_BYTES = 131072;

struct Params {
    const float *x, *mem, *w_in, *w_a2, *b_a, *gnw, *w_mkv, *w_out, *ln_g, *ln_b;
    float* out; unsigned char* ws;
};

DI unsigned pk2(float a, float b) { f32x2 f = {a, b}; bf16x2v v = __builtin_convertvector(f, bf16x2v); return __builtin_bit_cast(unsigned, v); }
DI float bf2f(short s) { return __uint_as_float(((unsigned)(u16)s) << 16); }
DI int crow(int reg, int h) { return (reg & 3) + 8 * (reg >> 2) + 4 * h; }
#define MFMA32(a, b, c) __builtin_amdgcn_mfma_f32_32x32x16_bf16((a), (b), (c), 0, 0, 0)
DI bf16x8 pack8(float a0, float a1, float a2, float a3, float a4, float a5, float a6, float a7) {
    u32x4 p = {pk2(a0, a1), pk2(a2, a3), pk2(a4, a5), pk2(a6, a7)}; return __builtin_bit_cast(bf16x8, p);
}
#define PACK_STEP(x, s) pack8((x)[8 * (s)], (x)[8 * (s) + 1], (x)[8 * (s) + 2], (x)[8 * (s) + 3], (x)[8 * (s) + 4], (x)[8 * (s) + 5], (x)[8 * (s) + 6], (x)[8 * (s) + 7])
DI bf16x8 ld_frag(const u16* p) { return *(const bf16x8*)p; }
DI bf16x8 ld_frag_perm(const u16* rowp, int h) {
    const s16x4 lo = *(const s16x4*)(rowp + 4 * h), hi = *(const s16x4*)(rowp + 8 + 4 * h);
    return __builtin_shufflevector(lo, hi, 0, 1, 2, 3, 4, 5, 6, 7);
}
DI float softplus_f(float z) { return fmaxf(z, 0.f) + __logf(1.f + __expf(-fabsf(z))); }
DI float logsig_f(float z) { return fminf(z, 0.f) - __logf(1.f + __expf(-fabsf(z))); }
DI float silu_f(float z) { return z / (1.f + __expf(-z)); }
DI f32x16 zero16() { f32x16 z; for (int i = 0; i < 16; ++i) z[i] = 0.f; return z; }
DI int otid() { int t = threadIdx.x; asm volatile("" : "+v"(t)); return t; }

namespace pg8 {
constexpr int BM = 256, BK = 64, HALF = 128, HTB = HALF * BK * 2, NXCD = 8, WGM = 8;
DI int lds_byte(int r, int c) { const int st = (r >> 4) * 2 + (c >> 5), rr = r & 15, cc = c & 31, ob = rr * 64 + cc * 2; return st * 1024 + (ob ^ (((ob >> 9) & 1) << 5)); }
DI void stage_rc(int b, int& R, int& C) { const int st = b / 1024, sb = b % 1024, swz = sb ^ (((sb >> 9) & 1) << 5); R = (st >> 1) * 16 + swz / 64; C = (st & 1) * 32 + (swz % 64) / 2; }
DI int perm32(int rho) { const int n = rho >> 4, i = rho & 15; return 8 * (i >> 2) + 4 * n + (i & 3); }
struct Unit { int pm, pn; };
struct Gemm { const u16* A; const u16* Bt; int M, N, K; int swap_from; };
struct StaticOrder {
    int nM, nN, nwg, G, c;
    DI void init(int M, int N, int G_, int c_) { nM = M / BM; nN = N / BM; nwg = nM * nN; G = G_; c = c_; }
    DI bool next(int i, Unit& u) const {
        const long L = (long)i * G + c; if (L >= nwg) return false;
        int wgid = (int)L; { const int q = nwg / NXCD, r = nwg % NXCD, xcd = wgid % NXCD, off = wgid / NXCD; wgid = (xcd < r ? xcd * (q + 1) : r * (q + 1) + (xcd - r) * q) + off; }
        const int nig = WGM * nN, gid = wgid / nig, fm = gid * WGM, gsz = (nM - fm) < WGM ? (nM - fm) : WGM;
        u.pm = fm + ((wgid % nig) % gsz); u.pn = (wgid % nig) / gsz; return true;
    }
};

template <class Epi>
DI void gemm_phase(LAS unsigned char* lds, const Gemm g, const StaticOrder& S, const Epi& E) {
    const int tid = otid(), wid = __builtin_amdgcn_readfirstlane(tid >> 6), lane = tid & 63, wr = wid >> 2, wc = wid & 3, fr = lane & 15, fq = lane >> 4;
    const int K = g.K, nt = K / BK;
    unsigned voffA[2], voffB[2];
#pragma unroll
    for (int i = 0; i < 2; ++i) { int R, C; stage_rc(tid * 16 + i * 8192, R, C); const int Rb = (R & ~31) + perm32(R & 31);
        voffA[i] = (unsigned)(R * K + C) * 2u; voffB[i] = (unsigned)(Rb * K + C) * 2u; }
    const size_t kstep = (size_t)(BK * 2);
    const size_t hstep = (size_t)HALF * K * 2;
    const size_t tstep = 2 * hstep;
    const unsigned ldsw = (unsigned)wid * 1024u;
    const int aoff = lds_byte(wr * 64 + fr, fq * 8), boff = lds_byte(wc * 32 + fr, fq * 8);
#define PG8_SA(b, h) (((b) * 2 + (h)) * HTB)
#define PG8_SB(b, h) ((4 + (b) * 2 + (h)) * HTB)
#define PG8_STAGE(bufoff, gbase, voff) do { _Pragma("unroll") for (int _i = 0; _i < 2; ++_i) \
        __builtin_amdgcn_global_load_lds((const unsigned*)((const char*)(gbase) + (voff)[_i]), (LAS unsigned*)(lds + (bufoff) + ldsw + _i * 8192), 16, 0, 0); } while (0)
#define PG8_LDA(dst, b, h) do { _Pragma("unroll") for (int m = 0; m < 4; ++m) _Pragma("unroll") for (int k = 0; k < 2; ++k) dst[m][k] = *(const LAS bf16x8*)(lds + PG8_SA(b, h) + aoff + m * 2048 + k * 1024); } while (0)
#define PG8_LDB(dst, b, h) do { _Pragma("unroll") for (int n = 0; n < 2; ++n) _Pragma("unroll") for (int k = 0; k < 2; ++k) dst[n][k] = *(const LAS bf16x8*)(lds + PG8_SB(b, h) + boff + n * 2048 + k * 1024); } while (0)
#define PG8_MMA(ai, bj, At, Bt) do { __builtin_amdgcn_s_setprio(1); _Pragma("unroll") for (int m = 0; m < 4; ++m) _Pragma("unroll") for (int n = 0; n < 2; ++n) _Pragma("unroll") for (int k = 0; k < 2; ++k) \
        acc[ai][bj][m][n] = __builtin_amdgcn_mfma_f32_16x16x32_bf16(Bt[n][k], At[m][k], acc[ai][bj][m][n], 0, 0, 0); __builtin_amdgcn_s_setprio(0); } while (0)
#define PG8_WAIT_V(n) asm volatile("s_waitcnt vmcnt(" #n ")" ::: "memory")
#define PG8_WAIT_L(n) asm volatile("s_waitcnt lgkmcnt(" #n ")" ::: "memory")
#define PG8_BAR __builtin_amdgcn_s_barrier()
#define PG8_SCHED __builtin_amdgcn_sched_barrier(0)
#define PG8_PTRS(u, pa, pb) do { const char* _a = (const char*)g.A + (size_t)(u).pm * tstep; const char* _b = (const char*)g.Bt + (size_t)(u).pn * tstep; \
        if ((u).pn >= g.swap_from) { pa = _b; pb = _a; } else { pa = _a; pb = _b; } } while (0)
    Unit cur, nxt; int ui = 0;
    if (!S.next(0, cur)) return;
    f32x4 acc[2][2][4][2];
#pragma unroll
    for (int a = 0; a < 2; ++a)
#pragma unroll
        for (int b = 0; b < 2; ++b)
#pragma unroll
            for (int m = 0; m < 4; ++m)
#pragma unroll
                for (int n = 0; n < 2; ++n) acc[a][b][m][n] = (f32x4){0.f, 0.f, 0.f, 0.f};
    bf16x8 At[4][2], B0[2][2], B1[2][2];
    const char* cA; const char* cB; PG8_PTRS(cur, cA, cB);
    PG8_STAGE(PG8_SB(0, 0), cB, voffB); PG8_STAGE(PG8_SA(0, 0), cA, voffA); PG8_STAGE(PG8_SB(0, 1), cB + hstep, voffB); PG8_STAGE(PG8_SA(0, 1), cA + hstep, voffA);
    if (wr == 1) PG8_BAR;
    PG8_WAIT_V(4); PG8_BAR;
    PG8_STAGE(PG8_SB(1, 0), cB + kstep, voffB); PG8_STAGE(PG8_SA(1, 0), cA + kstep, voffA); PG8_STAGE(PG8_SB(1, 1), cB + hstep + kstep, voffB);
    PG8_WAIT_V(6); PG8_BAR;
    for (;;) {
        const bool has_next = S.next(ui + 1, nxt);
        const char* nA = cA; const char* nB = cB;
        if (has_next) PG8_PTRS(nxt, nA, nB);
        for (int t = 0; t < nt; t += 2) {
            const bool last = (t == nt - 2);
            const char* a1 = cA + (size_t)(t + 1) * kstep;
            const char* a2 = last ? nA : cA + (size_t)(t + 2) * kstep; const char* b2 = last ? nB : cB + (size_t)(t + 2) * kstep;
            const char* a3 = a2 + kstep; const char* b3 = b2 + kstep;
            PG8_LDB(B0, 0, 0); PG8_SCHED; PG8_LDA(At, 0, 0); PG8_STAGE(PG8_SA(1, 1), a1 + hstep, voffA);
            PG8_WAIT_L(8); PG8_BAR; PG8_WAIT_L(0); PG8_MMA(0, 0, At, B0); PG8_BAR; PG8_SCHED;
            PG8_LDB(B1, 0, 1); PG8_STAGE(PG8_SB(0, 0), b2, voffB);
            PG8_BAR; PG8_WAIT_L(0); PG8_MMA(0, 1, At, B1); PG8_BAR;
            PG8_LDA(At, 0, 1); PG8_STAGE(PG8_SA(0, 0), a2, voffA);
            PG8_BAR; PG8_WAIT_L(0); PG8_MMA(1, 0, At, B0); PG8_BAR; PG8_SCHED;
            PG8_STAGE(PG8_SB(0, 1), b2 + hstep, voffB);
            PG8_WAIT_V(6); PG8_BAR; PG8_MMA(1, 1, At, B1); PG8_BAR;
            PG8_LDB(B0, 1, 0); PG8_SCHED; PG8_LDA(At, 1, 0); PG8_STAGE(PG8_SA(0, 1), a2 + hstep, voffA);
            PG8_WAIT_L(8); PG8_BAR; PG8_WAIT_L(0); PG8_MMA(0, 0, At, B0); PG8_BAR; PG8_SCHED;
            PG8_LDB(B1, 1, 1); PG8_STAGE(PG8_SB(1, 0), b3, voffB);
            PG8_BAR; PG8_WAIT_L(0); PG8_MMA(0, 1, At, B1); PG8_BAR;
            PG8_LDA(At, 1, 1); PG8_STAGE(PG8_SA(1, 0), a3, voffA);
            PG8_BAR; PG8_WAIT_L(0); PG8_MMA(1, 0, At, B0); PG8_BAR; PG8_SCHED;
            PG8_STAGE(PG8_SB(1, 1), b3 + hstep, voffB);
            PG8_WAIT_V(6); PG8_BAR; PG8_MMA(1, 1, At, B1); PG8_BAR;
        }
        E(acc, cur, wr, wc, fr, fq);
        if (!has_next) break;
#pragma unroll
        for (int a = 0; a < 2; ++a)
#pragma unroll
            for (int b = 0; b < 2; ++b)
#pragma unroll
                for (int m = 0; m < 4; ++m)
#pragma unroll
                    for (int n = 0; n < 2; ++n) acc[a][b][m][n] = (f32x4){0.f, 0.f, 0.f, 0.f};
        cur = nxt; cA = nA; cB = nB; ++ui;
    }
    PG8_WAIT_V(0);
    if (wr == 0) PG8_BAR;
    PG8_BAR;
#undef PG8_SA
#undef PG8_SB
#undef PG8_STAGE
#undef PG8_LDA
#undef PG8_LDB
#undef PG8_MMA
#undef PG8_WAIT_V
#undef PG8_WAIT_L
#undef PG8_BAR
#undef PG8_SCHED
#undef PG8_PTRS
}

DI void store_bf16_tile(const f32x4 (&acc)[2][2][4][2], u16* base, size_t ldc, int row0, int col0) {
#pragma unroll
    for (int ai = 0; ai < 2; ++ai)
#pragma unroll
        for (int m = 0; m < 4; ++m) { u16* rowp = base + (size_t)(row0 + ai * HALF + m * 16) * ldc + col0;
#pragma unroll
            for (int bj = 0; bj < 2; ++bj) { const f32x4 v0 = acc[ai][bj][m][0], v1 = acc[ai][bj][m][1];
                u32x4 w; w.x = pk2(v0[0], v0[1]); w.y = pk2(v0[2], v0[3]); w.z = pk2(v1[0], v1[1]); w.w = pk2(v1[2], v1[3]);
                *(u32x4*)(rowp + bj * HALF) = w; } }
}
struct EpiProj {
    u16* projn; float* loga; u16* projt; const float* b_a;
    DI void operator()(const f32x4 (&acc)[2][2][4][2], const Unit& u, int wr, int wc, int fr, int fq) const {
        if (u.pn < 9) store_bf16_tile(acc, projn, LDN, u.pm * BM + wr * 64 + fr, u.pn * BM + wc * 32 + 8 * fq);
        else if (u.pn >= 10) store_bf16_tile(acc, projt, MTOK, (u.pn - 10) * BM + wr * 64 + fr, u.pm * BM + wc * 32 + 8 * fq);
        else {
            const int row0 = u.pm * BM + wr * 64 + fr, col0 = wc * 32 + 8 * fq;
#pragma unroll
            for (int bj = 0; bj < 2; ++bj)
#pragma unroll
                for (int n = 0; n < 2; ++n) { const int col = col0 + bj * HALF + 4 * n; const f32x4 bv = *(const f32x4*)(b_a + col);
#pragma unroll
                    for (int ai = 0; ai < 2; ++ai)
#pragma unroll
                        for (int m = 0; m < 4; ++m) { const f32x4 v = acc[ai][bj][m][n] + bv; f32x4 o;
#pragma unroll
                            for (int j = 0; j < 4; ++j) o[j] = logsig_f(v[j]) * 0.0625f;
                            *(f32x4*)(loga + (size_t)(row0 + ai * HALF + m * 16) * 256 + col) = o; } }
        }
    }
};
struct EpiOut {
    u16* y;
    DI void operator()(const f32x4 (&acc)[2][2][4][2], const Unit& u, int wr, int wc, int fr, int fq) const {
        store_bf16_tile(acc, y, DM, u.pm * BM + wr * 64 + fr, u.pn * BM + wc * 32 + 8 * fq);
    }
};
}

DI void tr_item(const float* W, int ldw, int srccol0, float scale, u16* WT, int k0, LAS float* scr, int lane) {
#pragma unroll 8
    for (int i = 0; i < 32; ++i) { const int kk = 2 * i + (lane >> 5); scr[kk * 33 + (lane & 31)] = W[(size_t)(k0 + kk) * ldw + srccol0 + (lane & 31)]; }
    asm volatile("s_waitcnt lgkmcnt(0)" ::: "memory");
    const int c = lane & 7;
#pragma unroll
    for (int j = 0; j < 4; ++j) { const int n = (lane >> 3) + 8 * j; const LAS float* s = scr + (8 * c) * 33 + n;
        u32x4 o; o.x = pk2(s[0 * 33] * scale, s[1 * 33] * scale); o.y = pk2(s[2 * 33] * scale, s[3 * 33] * scale); o.z = pk2(s[4 * 33] * scale, s[5 * 33] * scale); o.w = pk2(s[6 * 33] * scale, s[7 * 33] * scale);
        *(u32x4*)(WT + (size_t)n * 1024 + k0 + 8 * c) = o; }
    asm volatile("s_waitcnt lgkmcnt(0)" ::: "memory");
}
DI bool bt_src(int n0, int& src, float& scale) {
    scale = 1.f;
    if (n0 < 256) { src = n0; scale = 0.125f; return true; }
    if (n0 < 512) { src = n0; return true; }
    if (n0 < 1024) { src = 1024 + (n0 - 512); return true; }
    if (n0 < 1280) { src = 1552 + (n0 - 1024); scale = 0.125f; return true; }
    if (n0 < 1536) { src = 1808 + (n0 - 1280); return true; }
    if (n0 < 1792) { src = 2320 + (n0 - 1536); return true; }
    if (n0 < 2048) { src = 2576 + (n0 - 1792); scale = 0.125f; return true; }
    if (n0 < 2304) { src = 2832 + (n0 - 2048); return true; }
    if (n0 < 2560) { src = 0; return false; }
    if (n0 < 2816) { src = 256 + (n0 - 2560); return true; }
    if (n0 < 3328) { src = 512 + (n0 - 2816); return true; }
    src = 2064 + (n0 - 3328); return true;
}
DI void prologue(const Params& p, LAS unsigned char* lds) {
    const int tid = otid(), lane = tid & 63, wave = tid >> 6;
    const int gw = blockIdx.x * 8 + wave, NGW = gridDim.x * 8;
    const size_t gt = (size_t)blockIdx.x * 512 + tid, NGT = (size_t)gridDim.x * 512;
    u16* bt = (u16*)(p.ws + WS_BT); u16* bo = (u16*)(p.ws + WS_BO);
    LAS float* scr = (LAS float*)(lds + wave * 8448);
    constexpr int I_IN = DEPTH * 112 * 16, I_OUT = DEPTH * 32 * 16;
    for (int it = gw; it < I_IN + I_OUT; it += NGW) {
        if (it < I_IN) { const int l = it / (112 * 16), r = it % (112 * 16), nb = r / 16, kb = r % 16; int src; float sc;
            if (bt_src(nb * 32, src, sc)) tr_item(p.w_in + (size_t)l * DM * DIN, DIN, src, sc, bt + ((size_t)l * NBT + nb * 32) * 1024, kb * 64, scr, lane); }
        else { const int r0 = it - I_IN, l = r0 / (32 * 16), r = r0 % (32 * 16), nb = r / 16, kb = r % 16;
            tr_item(p.w_out + (size_t)l * DM * DM, DM, nb * 32, 1.f, bo + ((size_t)l * 1024 + nb * 32) * 1024, kb * 64, scr, lane); }
    }
    for (size_t g = gt; g < (size_t)DEPTH * 256 * 128; g += NGT) {
        const int l = (int)(g >> 15), c = (int)(g >> 7) & 255, k = ((int)g & 127) * 8;
        float w2[16];
#pragma unroll
        for (int r = 0; r < 16; ++r) w2[r] = p.w_a2[((size_t)l * 16 + r) * 256 + c];
        float o[8];
#pragma unroll
        for (int kk = 0; kk < 8; ++kk) { const float* wr_ = p.w_in + ((size_t)l * DM + k + kk) * DIN + 1536; float a = 0.f;
#pragma unroll
            for (int r = 0; r < 16; r += 4) { const f32x4 v = *(const f32x4*)(wr_ + r); a += v[0] * w2[r] + v[1] * w2[r + 1] + v[2] * w2[r + 2] + v[3] * w2[r + 3]; }
            o[kk] = a; }
        u32x4 w; w.x = pk2(o[0], o[1]); w.y = pk2(o[2], o[3]); w.z = pk2(o[4], o[5]); w.w = pk2(o[6], o[7]);
        *(u32x4*)(bt + ((size_t)l * NBT + 2304 + c) * 1024 + k) = w;
    }
    { u16* xb = (u16*)(p.ws + WS_XB);
      for (size_t g = gt; g < (size_t)MTOK * DM / 8; g += NGT) { const f32x4 a = *(const f32x4*)(p.x + g * 8), b = *(const f32x4*)(p.x + g * 8 + 4);
          u32x4 w; w.x = pk2(a[0], a[1]); w.y = pk2(a[2], a[3]); w.z = pk2(b[0], b[1]); w.w = pk2(b[2], b[3]); *(u32x4*)(xb + g * 8) = w; } }
    { u16* km = (u16*)(p.ws + WS_KM); u16* vmt = (u16*)(p.ws + WS_VMT); const int r = lane & 31, h = lane >> 5;
      for (int it = gw; it < DEPTH * NB * 8 * 16; it += NGW) {
          const int nt = it & 15, mt = (it >> 4) & 7, b = (it >> 7) & 1, l = it >> 8;
          const float* arow = p.mem + ((size_t)b * NMEM + mt * 32 + r) * DM + 8 * h;
          const float* bcol = p.w_mkv + (size_t)l * DM * 512 + (size_t)(8 * h) * 512 + nt * 32 + r;
          f32x16 acc = zero16();
#pragma unroll 4
          for (int s = 0; s < 64; ++s) {
              const f32x4 a0 = *(const f32x4*)(arow + 16 * s), a1 = *(const f32x4*)(arow + 16 * s + 4);
              float bv[8];
#pragma unroll
              for (int j = 0; j < 8; ++j) bv[j] = bcol[(size_t)(16 * s + j) * 512];
              acc = MFMA32(pack8(a0[0], a0[1], a0[2], a0[3], a1[0], a1[1], a1[2], a1[3]), pack8(bv[0], bv[1], bv[2], bv[3], bv[4], bv[5], bv[6], bv[7]), acc);
          }
          const int n = nt * 32 + r;
#pragma unroll
          for (int i = 0; i < 16; ++i) { const int m = mt * 32 + crow(i, h); const u16 v = (u16)(pk2(acc[i], 0.f) & 0xffffu);
              if (n < 256) km[((((size_t)l * NB + b) * 4 + (n >> 6)) * 256 + m) * 64 + (n & 63)] = v;
              else { const int n2 = n - 256; vmt[((((size_t)l * NB + b) * 4 + (n2 >> 6)) * 64 + (n2 & 63)) * 256 + m] = v; } }
      } }
}

DI void gla_cumsum(const float* loga, int chunk, LAS float* G) {
    const int tid = otid();
    if (tid < 256) { const float* src = loga + (size_t)chunk * 64 * 256 + tid; float run = 0.f;
#pragma unroll 16
        for (int t = 0; t < 64; ++t) { run += src[(size_t)t * 256]; G[t * GS + tid] = run; } }
}
DI void gla_u_wave(const Params& p, int chunk, int wave, int lane, const LAS float* G) {
    const int hh = wave >> 1, vh = wave & 1, r = lane & 31, h = lane >> 5;
    const u16* projt = (const u16*)(p.ws + WS_PT); float* U = (float*)(p.ws + WS_U); float* gd = (float*)(p.ws + WS_GD);
    const size_t tok0 = (size_t)chunk * 64;
    f32x16 acc[2][2];
#pragma unroll
    for (int a = 0; a < 2; ++a)
#pragma unroll
        for (int b = 0; b < 2; ++b) acc[a][b] = zero16();
    float glast[2];
#pragma unroll
    for (int cb = 0; cb < 2; ++cb) glast[cb] = G[63 * GS + hh * 64 + 32 * cb + r];
#pragma unroll
    for (int s = 0; s < 4; ++s) {
        bf16x8 af[2], bfr[2];
#pragma unroll
        for (int rb = 0; rb < 2; ++rb) af[rb] = ld_frag(projt + (size_t)(PT_GV + hh * 128 + 64 * vh + 32 * rb + r) * MTOK + tok0 + 16 * s + 8 * h);
#pragma unroll
        for (int cb = 0; cb < 2; ++cb) { const int dk = 32 * cb + r; const bf16x8 kt = ld_frag(projt + (size_t)(PT_GK + hh * 64 + dk) * MTOK + tok0 + 16 * s + 8 * h);
            float v[8];
#pragma unroll
            for (int j = 0; j < 8; ++j) { const int t = 16 * s + 8 * h + j; v[j] = bf2f(kt[j]) * __expf(glast[cb] - G[t * GS + hh * 64 + dk]); }
            bfr[cb] = pack8(v[0], v[1], v[2], v[3], v[4], v[5], v[6], v[7]); }
#pragma unroll
        for (int rb = 0; rb < 2; ++rb)
#pragma unroll
            for (int cb = 0; cb < 2; ++cb) acc[rb][cb] = MFMA32(af[rb], bfr[cb], acc[rb][cb]);
    }
    float* Ub = U + ((size_t)chunk * 4 + hh) * 8192;
#pragma unroll
    for (int rb = 0; rb < 2; ++rb)
#pragma unroll
        for (int cb = 0; cb < 2; ++cb)
#pragma unroll
            for (int i = 0; i < 16; ++i) Ub[(size_t)(64 * vh + 32 * rb + crow(i, h)) * 64 + 32 * cb + r] = acc[rb][cb][i];
    if (vh == 0) gd[((size_t)chunk * 4 + hh) * 64 + lane] = __expf(G[63 * GS + hh * 64 + lane]);
}
DI void sb_item(const Params& p, int item, int lane) {
    const int head = item & 3, tile = item >> 2, b = tile >> 9, tt = tile & 511, r = lane & 31, h = lane >> 5;
    const u16* projn = (const u16*)(p.ws + WS_PN); const u16* projt = (const u16*)(p.ws + WS_PT); u16* mix = (u16*)(p.ws + WS_MIX);
    const size_t tok0 = (size_t)b * SEQ + (size_t)tt * 32;
    bf16x8 qf[4];
    { const u16* qrow = projn + (tok0 + r) * LDN + PN_SQ + head * 64;
#pragma unroll
      for (int s = 0; s < 4; ++s) qf[s] = ld_frag(qrow + 16 * s + 8 * h); }
    bf16x8 tri[2];
#pragma unroll
    for (int s = 0; s < 2; ++s)
#pragma unroll
        for (int j = 0; j < 8; ++j) tri[s][j] = (16 * s + 8 * (j >> 2) + 4 * h + (j & 3) >= r) ? (short)0x3F80 : (short)0;
    const u16* vt0 = projt + (size_t)(PT_SV + head * 64 + r) * MTOK + (size_t)b * SEQ;
    const u16* vt1 = vt0 + (size_t)32 * MTOK;
    f32x16 o0 = zero16(), o1 = zero16();
    float R = 0.f;
    const int qpos = tt * 32 + r;
    for (int kb = tt; kb >= 0; --kb) {
        const u16* krow = projn + ((size_t)b * SEQ + (size_t)kb * 32 + r) * LDN + PN_SK + head * 64;
        f32x16 z = zero16();
#pragma unroll
        for (int s = 0; s < 4; ++s) z = MFMA32(ld_frag(krow + 16 * s + 8 * h), qf[s], z);
        const bool diag = (kb == tt);
        f32x16 sp;
#pragma unroll
        for (int i = 0; i < 16; ++i) { const bool ok = !diag || (kb * 32 + crow(i, h) < qpos); sp[i] = ok ? softplus_f(z[i]) : 0.f; }
        f32x16 tm = zero16();
#pragma unroll
        for (int s = 0; s < 2; ++s) tm = MFMA32(tri[s], PACK_STEP(sp, s), tm);
        f32x16 pw;
#pragma unroll
        for (int i = 0; i < 16; ++i) { const bool ok = !diag || (kb * 32 + crow(i, h) < qpos); pw[i] = ok ? __expf(z[i] - tm[i] - R) : 0.f; }
#pragma unroll
        for (int s = 0; s < 2; ++s) { const bf16x8 pb = PACK_STEP(pw, s);
            o0 = MFMA32(ld_frag_perm(vt0 + kb * 32 + 16 * s, h), pb, o0);
            o1 = MFMA32(ld_frag_perm(vt1 + kb * 32 + 16 * s, h), pb, o1); }
        R += __shfl(tm[0], r);
        if (__all(R > SB_THR)) break;
    }
    const u16* grow = projn + (tok0 + r) * LDN + PN_SG + head * 64;
    u16* mrow = mix + (tok0 + r) * DM + 512 + head * 64;
#pragma unroll
    for (int db = 0; db < 2; ++db)
#pragma unroll
        for (int g = 0; g < 4; ++g) { const int d = 32 * db + 8 * g + 4 * h; const s16x4 gv = *(const s16x4*)(grow + d);
            float o[4];
#pragma unroll
            for (int e = 0; e < 4; ++e) o[e] = (db ? o1[4 * g + e] : o0[4 * g + e]) * silu_f(bf2f(gv[e]));
            u32x2 w; w.x = pk2(o[0], o[1]); w.y = pk2(o[2], o[3]); *(u32x2*)(mrow + d) = w; }
}
DI void mem_item(const Params& p, int l, int item, int lane) {
    const int head = item & 3, tile = item >> 2, b = tile >> 9, tt = tile & 511, r = lane & 31, h = lane >> 5;
    const u16* projn = (const u16*)(p.ws + WS_PN); u16* mix = (u16*)(p.ws + WS_MIX);
    const u16* km = (const u16*)(p.ws + WS_KM) + (((size_t)l * NB + b) * 4 + head) * 256 * 64;
    const u16* vmt = (const u16*)(p.ws + WS_VMT) + (((size_t)l * NB + b) * 4 + head) * 64 * 256;
    const size_t tok0 = (size_t)b * SEQ + (size_t)tt * 32;
    bf16x8 qf[4];
    { const u16* qrow = projn + (tok0 + r) * LDN + PN_MQ + head * 64;
#pragma unroll
      for (int s = 0; s < 4; ++s) qf[s] = ld_frag(qrow + 16 * s + 8 * h); }
    float mx = -3.0e38f;
#pragma unroll 2
    for (int mb = 0; mb < 8; ++mb) { f32x16 z = zero16();
#pragma unroll
        for (int s = 0; s < 4; ++s) z = MFMA32(ld_frag(km + (size_t)(mb * 32 + r) * 64 + 16 * s + 8 * h), qf[s], z);
#pragma unroll
        for (int i = 0; i < 16; ++i) mx = fmaxf(mx, z[i]); }
    mx = fmaxf(mx, __shfl_xor(mx, 32));
    f32x16 o0 = zero16(), o1 = zero16(); float sum = 0.f;
#pragma unroll 2
    for (int mb = 0; mb < 8; ++mb) { f32x16 z = zero16();
#pragma unroll
        for (int s = 0; s < 4; ++s) z = MFMA32(ld_frag(km + (size_t)(mb * 32 + r) * 64 + 16 * s + 8 * h), qf[s], z);
        f32x16 pw;
#pragma unroll
        for (int i = 0; i < 16; ++i) { pw[i] = __expf(z[i] - mx); sum += pw[i]; }
#pragma unroll
        for (int s = 0; s < 2; ++s) { const bf16x8 pb = PACK_STEP(pw, s);
            o0 = MFMA32(ld_frag_perm(vmt + (size_t)r * 256 + mb * 32 + 16 * s, h), pb, o0);
            o1 = MFMA32(ld_frag_perm(vmt + (size_t)(32 + r) * 256 + mb * 32 + 16 * s, h), pb, o1); } }
    sum += __shfl_xor(sum, 32);
    const float inv = 1.f / sum;
    const u16* grow = projn + (tok0 + r) * LDN + PN_MG + head * 64;
    u16* mrow = mix + (tok0 + r) * DM + 768 + head * 64;
#pragma unroll
    for (int db = 0; db < 2; ++db)
#pragma unroll
        for (int g = 0; g < 4; ++g) { const int d = 32 * db + 8 * g + 4 * h; const s16x4 gv = *(const s16x4*)(grow + d);
            float o[4];
#pragma unroll
            for (int e = 0; e < 4; ++e) o[e] = (db ? o1[4 * g + e] : o0[4 * g + e]) * inv * silu_f(bf2f(gv[e]));
            u32x2 w; w.x = pk2(o[0], o[1]); w.y = pk2(o[2], o[3]); *(u32x2*)(mrow + d) = w; }
}
DI void gla_scan(const Params& p) {
    const int tid = otid(); if (tid >= 256) return;
    const int e = blockIdx.x * 256 + tid; if (e >= 65536) return;
    float* U = (float*)(p.ws + WS_U); const float* gd = (const float*)(p.ws + WS_GD);
    const int bh = e >> 13, b = bh >> 2, hh = bh & 3, idx = e & 8191, dk = idx & 63;
    float s = 0.f;
    for (int n0 = 0; n0 < 256; n0 += 8) {
        float u[8], g[8];
#pragma unroll
        for (int j = 0; j < 8; ++j) { const size_t base = ((size_t)(b * 256 + n0 + j)) * 4 + hh; u[j] = U[base * 8192 + idx]; g[j] = gd[base * 64 + dk]; }
#pragma unroll
        for (int j = 0; j < 8; ++j) { const size_t base = ((size_t)(b * 256 + n0 + j)) * 4 + hh; U[base * 8192 + idx] = s; s = g[j] * s + u[j]; }
    }
}
DI void gla_out_wave(const Params& p, int l, int chunk, int wave, int lane, const LAS float* G) {
    const int hh = wave >> 1, ih = wave & 1, r = lane & 31, h = lane >> 5;
    const u16* projn = (const u16*)(p.ws + WS_PN); const u16* projt = (const u16*)(p.ws + WS_PT); const float* U = (const float*)(p.ws + WS_U); u16* mix = (u16*)(p.ws + WS_MIX);
    const size_t tok0 = (size_t)chunk * 64;
    const int ti = 32 * ih + r;
    bf16x8 qf[4];
    { const u16* qrow = projn + (tok0 + ti) * LDN + PN_GQ + hh * 64;
#pragma unroll
      for (int s = 0; s < 4; ++s) { const bf16x8 q = ld_frag(qrow + 16 * s + 8 * h); const LAS float* gp = G + ti * GS + hh * 64 + 16 * s + 8 * h;
          const f32x4 g0 = *(const LAS f32x4*)gp, g1 = *(const LAS f32x4*)(gp + 4);
          qf[s] = pack8(bf2f(q[0]) * __expf(g0[0]), bf2f(q[1]) * __expf(g0[1]), bf2f(q[2]) * __expf(g0[2]), bf2f(q[3]) * __expf(g0[3]),
                        bf2f(q[4]) * __expf(g1[0]), bf2f(q[5]) * __expf(g1[1]), bf2f(q[6]) * __expf(g1[2]), bf2f(q[7]) * __expf(g1[3])); } }
    f32x16 o[4];
#pragma unroll
    for (int rb = 0; rb < 4; ++rb) o[rb] = zero16();
    for (int jb = 0; jb <= ih; ++jb) {
        f32x16 am = zero16();
        const int tj = 32 * jb + r;
#pragma unroll
        for (int s = 0; s < 4; ++s) { const bf16x8 k = ld_frag(projn + (tok0 + tj) * LDN + PN_GK + hh * 64 + 16 * s + 8 * h); const LAS float* gp = G + tj * GS + hh * 64 + 16 * s + 8 * h;
            const f32x4 g0 = *(const LAS f32x4*)gp, g1 = *(const LAS f32x4*)(gp + 4);
            const bf16x8 kf = pack8(bf2f(k[0]) * __expf(-g0[0]), bf2f(k[1]) * __expf(-g0[1]), bf2f(k[2]) * __expf(-g0[2]), bf2f(k[3]) * __expf(-g0[3]),
                                    bf2f(k[4]) * __expf(-g1[0]), bf2f(k[5]) * __expf(-g1[1]), bf2f(k[6]) * __expf(-g1[2]), bf2f(k[7]) * __expf(-g1[3]));
            am = MFMA32(kf, qf[s], am); }
#pragma unroll
        for (int i = 0; i < 16; ++i) am[i] = (32 * jb + crow(i, h) <= ti) ? am[i] : 0.f;
#pragma unroll
        for (int s = 0; s < 2; ++s) { const bf16x8 pb = PACK_STEP(am, s);
#pragma unroll
            for (int rb = 0; rb < 4; ++rb) o[rb] = MFMA32(ld_frag_perm(projt + (size_t)(PT_GV + hh * 128 + 32 * rb + r) * MTOK + tok0 + 32 * jb + 16 * s, h), pb, o[rb]); }
    }
    { const float* Sb = U + ((size_t)chunk * 4 + hh) * 8192;
#pragma unroll
      for (int s = 0; s < 4; ++s)
#pragma unroll
          for (int rb = 0; rb < 4; ++rb) { const float* sp_ = Sb + (size_t)(32 * rb + r) * 64 + 16 * s + 8 * h; const f32x4 a0 = *(const f32x4*)sp_, a1 = *(const f32x4*)(sp_ + 4);
              o[rb] = MFMA32(pack8(a0[0], a0[1], a0[2], a0[3], a1[0], a1[1], a1[2], a1[3]), qf[s], o[rb]); } }
    float ss = 0.f;
#pragma unroll
    for (int rb = 0; rb < 4; ++rb)
#pragma unroll
        for (int i = 0; i < 16; ++i) ss += o[rb][i] * o[rb][i];
    ss += __shfl_xor(ss, 32);
    const float rinv = rsqrtf(ss * (1.f / 128.f) + RMS_EPS);
    const u16* grow = projn + (tok0 + ti) * LDN + PN_GG + hh * 128;
    u16* mrow = mix + (tok0 + ti) * DM + hh * 128;
    const float* nw = p.gnw + (size_t)l * 128;
#pragma unroll
    for (int rb = 0; rb < 4; ++rb)
#pragma unroll
        for (int g = 0; g < 4; ++g) { const int dv = 32 * rb + 8 * g + 4 * h; const s16x4 gv = *(const s16x4*)(grow + dv); const f32x4 wv = *(const f32x4*)(nw + dv);
            float ov[4];
#pragma unroll
            for (int e = 0; e < 4; ++e) ov[e] = o[rb][4 * g + e] * rinv * wv[e] * silu_f(bf2f(gv[e]));
            u32x2 w; w.x = pk2(ov[0], ov[1]); w.y = pk2(ov[2], ov[3]); *(u32x2*)(mrow + dv) = w; }
}
DI void ln_phase(const Params& p, int l) {
    const int tid = otid(), lane = tid & 63, gw = blockIdx.x * 8 + (tid >> 6), NGW = gridDim.x * 8;
    const float* xin = l == 0 ? p.x : p.out; const u16* y = (const u16*)(p.ws + WS_PN); u16* xb = (u16*)(p.ws + WS_XB);
    const float* gam = p.ln_g + (size_t)l * DM; const float* bet = p.ln_b + (size_t)l * DM;
    for (int row = gw; row < MTOK; row += NGW) {
        f32x4 v[4]; float s = 0.f;
#pragma unroll
        for (int j = 0; j < 4; ++j) { const int c = 4 * lane + 256 * j; const f32x4 xv = *(const f32x4*)(xin + (size_t)row * DM + c); const s16x4 yv = *(const s16x4*)(y + (size_t)row * DM + c);
#pragma unroll
            for (int e = 0; e < 4; ++e) { v[j][e] = ALPHA_DN * xv[e] + bf2f(yv[e]); s += v[j][e]; } }
#pragma unroll
        for (int o = 1; o < 64; o <<= 1) s += __shfl_xor(s, o);
        const float mean = s * (1.f / DM); float q = 0.f;
#pragma unroll
        for (int j = 0; j < 4; ++j)
#pragma unroll
            for (int e = 0; e < 4; ++e) { v[j][e] -= mean; q += v[j][e] * v[j][e]; }
#pragma unroll
        for (int o = 1; o < 64; o <<= 1) q += __shfl_xor(q, o);
        const float rstd = rsqrtf(q * (1.f / DM) + LN_EPS);
#pragma unroll
        for (int j = 0; j < 4; ++j) { const int c = 4 * lane + 256 * j; const f32x4 gv = *(const f32x4*)(gam + c), bv = *(const f32x4*)(bet + c); f32x4 ov;
#pragma unroll
            for (int e = 0; e < 4; ++e) ov[e] = v[j][e] * rstd * gv[e] + bv[e];
            *(f32x4*)(p.out + (size_t)row * DM + c) = ov;
            u32x2 w; w.x = pk2(ov[0], ov[1]); w.y = pk2(ov[2], ov[3]); *(u32x2*)(xb + (size_t)row * DM + c) = w; }
    }
}

__global__ __launch_bounds__(512, 2) void fwd_megakernel(Params p) {
    extern __shared__ __attribute__((aligned(16))) unsigned char shm[];
    cg::grid_group grid = cg::this_grid();
    LAS unsigned char* lds = (LAS unsigned char*)shm;
    prologue(p, lds);
    grid.sync();
#pragma unroll 1
    for (int l = 0; l < DEPTH; ++l) {
        { pg8::Gemm g{(const u16*)(p.ws + WS_XB), (const u16*)(p.ws + WS_BT) + (size_t)l * NBT * 1024, MTOK, NBT, DM, 10};
          pg8::StaticOrder S; S.init(MTOK, NBT, (int)gridDim.x, (int)blockIdx.x);
          pg8::EpiProj E{(u16*)(p.ws + WS_PN), (float*)(p.ws + WS_LA), (u16*)(p.ws + WS_PT), p.b_a + (size_t)l * 256};
          pg8::gemm_phase<pg8::EpiProj>(lds, g, S, E); }
        grid.sync();
        { const int tid = otid(), lane = tid & 63, wave = tid >> 6;
          for (int c = blockIdx.x; c < 512; c += gridDim.x) {
            gla_cumsum((const float*)(p.ws + WS_LA), c, (LAS float*)lds);
            __syncthreads();
            gla_u_wave(p, c, wave, lane, (const LAS float*)lds);
            __syncthreads();
          } }
        { const int tid = otid(), lane = tid & 63, gw = blockIdx.x * 8 + (tid >> 6), NGW = gridDim.x * 8;
          for (int it = gw; it < 4096; it += NGW) sb_item(p, it, lane); }
        { const int tid = otid(), lane = tid & 63, gw = blockIdx.x * 8 + (tid >> 6), NGW = gridDim.x * 8;
          for (int it = gw; it < 4096; it += NGW) mem_item(p, l, it, lane); }
        grid.sync();
        gla_scan(p);
        grid.sync();
        { const int tid = otid(), lane = tid & 63, wave = tid >> 6;
          for (int c = blockIdx.x; c < 512; c += gridDim.x) {
            gla_cumsum((const float*)(p.ws + WS_LA), c, (LAS float*)lds);
            __syncthreads();
            gla_out_wave(p, l, c, wave, lane, (const LAS float*)lds);
            __syncthreads();
          } }
        grid.sync();
        { pg8::Gemm g{(const u16*)(p.ws + WS_MIX), (const u16*)(p.ws + WS_BO) + (size_t)l * 1024 * 1024, MTOK, DM, DM, 1 << 30};
          pg8::StaticOrder S; S.init(MTOK, DM, (int)gridDim.x, (int)blockIdx.x);
          pg8::EpiOut E{(u16*)(p.ws + WS_PN)};
          pg8::gemm_phase<pg8::EpiOut>(lds, g, S, E); }
        grid.sync();
        ln_phase(p, l);
        grid.sync();
    }
}

extern "C" void kernel_launch(void* const* d_in, const int* in_sizes, int n_in, void* d_out, int out_size, void* d_ws, size_t ws_size, hipStream_t stream) {
    static int grid = 0;
    if (grid == 0) {
        if (n_in != 10 || in_sizes[0] != MTOK * DM || out_size != MTOK * DM || ws_size < WS_END) {
            fprintf(stderr, "kernel_launch: unexpected shapes or workspace (n_in %d, ws %zu, need %zu)\n", n_in, ws_size, (size_t)WS_END); grid = -1; return; }
        int dev = 0, cus = 0, per_cu = 0;
        (void)hipGetDevice(&dev);
        (void)hipDeviceGetAttribute(&cus, hipDeviceAttributeMultiprocessorCount, dev);
        if (hipFuncSetAttribute((const void*)fwd_megakernel, hipFuncAttributeMaxDynamicSharedMemorySize, LDS_BYTES) != hipSuccess) { fprintf(stderr, "kernel_launch: hipFuncSetAttribute failed\n"); grid = -1; return; }
        (void)hipOccupancyMaxActiveBlocksPerMultiprocessor(&per_cu, (const void*)fwd_megakernel, 512, LDS_BYTES);
        if (per_cu < 1) { fprintf(stderr, "kernel_launch: occupancy query says %d blocks per CU\n", per_cu); per_cu = 1; }
        (void)hipGetLastError();
        grid = cus;
    }
    if (grid < 0) return;
    Params p{};
    p.x = (const float*)d_in[0]; p.mem = (const float*)d_in[1]; p.w_in = (const float*)d_in[2]; p.w_a2 = (const float*)d_in[3]; p.b_a = (const float*)d_in[4];
    p.gnw = (const float*)d_in[5]; p.w_mkv = (const float*)d_in[6]; p.w_out = (const float*)d_in[7]; p.ln_g = (const float*)d_in[8]; p.ln_b = (const float*)d_in[9];
    p.out = (float*)d_out; p.ws = (unsigned char*)d_ws;
    void* args[] = {&p};
    hipError_t e = hipLaunchCooperativeKernel((const void*)fwd_megakernel, dim3(grid), dim3(512), args, LDS_BYTES, stream);
    if (e != hipSuccess) fprintf(stderr, "cooperative launch failed: %s (grid %d)\n", hipGetErrorString(e), grid);
}
```

```cpp
#include <hip/hip_runtime.h>
#include <hip/hip_cooperative_groups.h>
#include <cstdio>
namespace cg = cooperative_groups;

#define DI __device__ __forceinline__
#define LAS __attribute__((address_space(3)))
typedef unsigned short u16;
typedef short bf16x8 __attribute__((ext_vector_type(8)));
typedef short s16x4 __attribute__((ext_vector_type(4)));
typedef float f32x2 __attribute__((ext_vector_type(2)));
typedef float f32x4 __attribute__((ext_vector_type(4)));
typedef float f32x16 __attribute__((ext_vector_type(16)));
typedef unsigned u32x2 __attribute__((ext_vector_type(2)));
typedef unsigned u32x4 __attribute__((ext_vector_type(4)));
typedef __bf16 bf16x2v __attribute__((ext_vector_type(2)));

constexpr int SEQ = 16384, NB = 2, MTOK = NB * SEQ, DM = 1024, DEPTH = 4, NMEM = 256, DIN = 3088;
constexpr int LDN = 2304;
constexpr int PN_GQ = 0, PN_GK = 256, PN_GG = 512, PN_SQ = 1024, PN_SK = 1280, PN_SG = 1536, PN_MQ = 1792, PN_MG = 2048;
constexpr int NBT = 3584;
constexpr int PT_GK = 0, PT_GV = 256, PT_SV = 768;
constexpr float ALPHA_DN = 1.681792830507429f;
constexpr float LN_EPS = 1e-5f, RMS_EPS = 1e-6f;
constexpr float SB_THR = 40.0f;
constexpr int GS = 260;

constexpr size_t WS_BT = 0;
constexpr size_t WS_BO = WS_BT + (size_t)DEPTH * NBT * 1024 * 2;
constexpr size_t WS_KM = WS_BO + (size_t)DEPTH * 1024 * 1024 * 2;
constexpr size_t WS_VMT = WS_KM + (size_t)DEPTH * NB * 4 * 256 * 64 * 2;
constexpr size_t WS_XB = WS_VMT + (size_t)DEPTH * NB * 4 * 256 * 64 * 2;
constexpr size_t WS_PN = WS_XB + (size_t)MTOK * 1024 * 2;
constexpr size_t WS_LA = WS_PN + (size_t)MTOK * LDN * 2;
constexpr size_t WS_PT = WS_LA + (size_t)MTOK * 256 * 4;
constexpr size_t WS_MIX = WS_PT + (size_t)1024 * MTOK * 2;
constexpr size_t WS_U = WS_MIX + (size_t)MTOK * 1024 * 2;
constexpr size_t WS_GD = WS_U + (size_t)512 * 4 * 128 * 64 * 4;
constexpr size_t WS_SB = WS_GD + (size_t)512 * 4 * 64 * 4;
constexpr size_t WS_BAR = WS_SB + (size_t)512 * 4 * 128 * 64 * 2;
constexpr size_t WS_END = WS_BAR + 16384;
constexpr int LDS_BYTES = 131072 + 64;
#define REP_A 1
#define REP_B1 2
#define REP_B2 1
#define REP_B3 1
#define REP_C 1
#define REP_D 1
#define REP_E 1
#define EXTRA_SYNC 0

struct Params {
    const float *x, *mem, *w_in, *w_a2, *b_a, *gnw, *w_mkv, *w_out, *ln_g, *ln_b;
    float* out; unsigned char* ws;
};

DI unsigned pk2(float a, float b) { f32x2 f = {a, b}; bf16x2v v = __builtin_convertvector(f, bf16x2v); return __builtin_bit_cast(unsigned, v); }
DI float bf2f(short s) { return __uint_as_float(((unsigned)(u16)s) << 16); }
DI int crow(int reg, int h) { return (reg & 3) + 8 * (reg >> 2) + 4 * h; }
#define MFMA32(a, b, c) __builtin_amdgcn_mfma_f32_32x32x16_bf16((a), (b), (c), 0, 0, 0)
DI bf16x8 pack8(float a0, float a1, float a2, float a3, float a4, float a5, float a6, float a7) {
    u32x4 p = {pk2(a0, a1), pk2(a2, a3), pk2(a4, a5), pk2(a6, a7)}; return __builtin_bit_cast(bf16x8, p);
}
#define PACK_STEP(x, s) pack8((x)[8 * (s)], (x)[8 * (s) + 1], (x)[8 * (s) + 2], (x)[8 * (s) + 3], (x)[8 * (s) + 4], (x)[8 * (s) + 5], (x)[8 * (s) + 6], (x)[8 * (s) + 7])
DI bf16x8 ld_frag(const u16* p) { return *(const bf16x8*)p; }
DI bf16x8 ld_frag_perm(const u16* rowp, int h) {
    const s16x4 lo = *(const s16x4*)(rowp + 4 * h), hi = *(const s16x4*)(rowp + 8 + 4 * h);
    return __builtin_shufflevector(lo, hi, 0, 1, 2, 3, 4, 5, 6, 7);
}
DI float softplus_f(float z) { return fmaxf(z, 0.f) + __logf(1.f + __expf(-fabsf(z))); }
DI float logsig_f(float z) { return fminf(z, 0.f) - __logf(1.f + __expf(-fabsf(z))); }
DI float silu_f(float z) { return z / (1.f + __expf(-z)); }
DI f32x16 zero16() { f32x16 z; for (int i = 0; i < 16; ++i) z[i] = 0.f; return z; }
DI int otid() { int t = threadIdx.x; asm volatile("" : "+v"(t)); return t; }

namespace pg8 {
constexpr int BM = 256, BK = 64, HALF = 128, HTB = HALF * BK * 2, NXCD = 8, WGM = 8;
DI int lds_byte(int r, int c) { const int st = (r >> 4) * 2 + (c >> 5), rr = r & 15, cc = c & 31, ob = rr * 64 + cc * 2; return st * 1024 + (ob ^ (((ob >> 9) & 1) << 5)); }
DI void stage_rc(int b, int& R, int& C) { const int st = b / 1024, sb = b % 1024, swz = sb ^ (((sb >> 9) & 1) << 5); R = (st >> 1) * 16 + swz / 64; C = (st & 1) * 32 + (swz % 64) / 2; }
DI int perm32(int rho) { const int n = rho >> 4, i = rho & 15; return 8 * (i >> 2) + 4 * n + (i & 3); }
struct Unit { int pm, pn; };
struct Gemm { const u16* A; const u16* Bt; int M, N, K; int swap_from; };
struct StaticOrder {
    int nM, nN, nwg, G, c;
    DI void init(int M, int N, int G_, int c_) { nM = M / BM; nN = N / BM; nwg = nM * nN; G = G_; c = c_; }
    DI bool next(int i, Unit& u) const {
        const long L = (long)i * G + c; if (L >= nwg) return false;
        int wgid = (int)L; { const int q = nwg / NXCD, r = nwg % NXCD, xcd = wgid % NXCD, off = wgid / NXCD; wgid = (xcd < r ? xcd * (q + 1) : r * (q + 1) + (xcd - r) * q) + off; }
        const int nig = WGM * nN, gid = wgid / nig, fm = gid * WGM, gsz = (nM - fm) < WGM ? (nM - fm) : WGM;
        u.pm = fm + ((wgid % nig) % gsz); u.pn = (wgid % nig) / gsz; return true;
    }
};

template <class Epi>
DI void gemm_phase(LAS unsigned char* lds, const Gemm g, const StaticOrder& S, const Epi& E) {
    const int tid = otid(), wid = __builtin_amdgcn_readfirstlane(tid >> 6), lane = tid & 63, wr = wid >> 2, wc = wid & 3, fr = lane & 15, fq = lane >> 4;
    const int K = g.K, nt = K / BK;
    unsigned voffA[2], voffB[2];
#pragma unroll
    for (int i = 0; i < 2; ++i) { int R, C; stage_rc(tid * 16 + i * 8192, R, C); const int Rb = (R & ~31) + perm32(R & 31);
        voffA[i] = (unsigned)(R * K + C) * 2u; voffB[i] = (unsigned)(Rb * K + C) * 2u; }
    const size_t kstep = (size_t)(BK * 2);
    const size_t hstep = (size_t)HALF * K * 2;
    const size_t tstep = 2 * hstep;
    const unsigned ldsw = (unsigned)wid * 1024u;
    const int aoff = lds_byte(wr * 64 + fr, fq * 8), boff = lds_byte(wc * 32 + fr, fq * 8);
#define PG8_SA(b, h) (((b) * 2 + (h)) * HTB)
#define PG8_SB(b, h) ((4 + (b) * 2 + (h)) * HTB)
#define PG8_STAGE(bufoff, gbase, voff) do { _Pragma("unroll") for (int _i = 0; _i < 2; ++_i) \
        __builtin_amdgcn_global_load_lds((const unsigned*)((const char*)(gbase) + (voff)[_i]), (LAS unsigned*)(lds + (bufoff) + ldsw + _i * 8192), 16, 0, 0); } while (0)
#define PG8_LDA(dst, b, h) do { _Pragma("unroll") for (int m = 0; m < 4; ++m) _Pragma("unroll") for (int k = 0; k < 2; ++k) dst[m][k] = *(const LAS bf16x8*)(lds + PG8_SA(b, h) + aoff + m * 2048 + k * 1024); } while (0)
#define PG8_LDB(dst, b, h) do { _Pragma("unroll") for (int n = 0; n < 2; ++n) _Pragma("unroll") for (int k = 0; k < 2; ++k) dst[n][k] = *(const LAS bf16x8*)(lds + PG8_SB(b, h) + boff + n * 2048 + k * 1024); } while (0)
#define PG8_MMA(ai, bj, At, Bt) do { __builtin_amdgcn_s_setprio(1); _Pragma("unroll") for (int m = 0; m < 4; ++m) _Pragma("unroll") for (int n = 0; n < 2; ++n) _Pragma("unroll") for (int k = 0; k < 2; ++k) \
        acc[ai][bj][m][n] = __builtin_amdgcn_mfma_f32_16x16x32_bf16(Bt[n][k], At[m][k], acc[ai][bj][m][n], 0, 0, 0); __builtin_amdgcn_s_setprio(0); } while (0)
#define PG8_WAIT_V(n) asm volatile("s_waitcnt vmcnt(" #n ")" ::: "memory")
#define PG8_WAIT_L(n) asm volatile("s_waitcnt lgkmcnt(" #n ")" ::: "memory")
#define PG8_BAR __builtin_amdgcn_s_barrier()
#define PG8_SCHED __builtin_amdgcn_sched_barrier(0)
#define PG8_PTRS(u, pa, pb) do { const char* _a = (const char*)g.A + (size_t)(u).pm * tstep; const char* _b = (const char*)g.Bt + (size_t)(u).pn * tstep; \
        if ((u).pn >= g.swap_from) { pa = _b; pb = _a; } else { pa = _a; pb = _b; } } while (0)
    Unit cur, nxt; int ui = 0;
    if (!S.next(0, cur)) return;
    f32x4 acc[2][2][4][2];
#pragma unroll
    for (int a = 0; a < 2; ++a)
#pragma unroll
        for (int b = 0; b < 2; ++b)
#pragma unroll
            for (int m = 0; m < 4; ++m)
#pragma unroll
                for (int n = 0; n < 2; ++n) acc[a][b][m][n] = (f32x4){0.f, 0.f, 0.f, 0.f};
    bf16x8 At[4][2], B0[2][2], B1[2][2];
    const char* cA; const char* cB; PG8_PTRS(cur, cA, cB);
    PG8_STAGE(PG8_SB(0, 0), cB, voffB); PG8_STAGE(PG8_SA(0, 0), cA, voffA); PG8_STAGE(PG8_SB(0, 1), cB + hstep, voffB); PG8_STAGE(PG8_SA(0, 1), cA + hstep, voffA);
    if (wr == 1) PG8_BAR;
    PG8_WAIT_V(4); PG8_BAR;
    PG8_STAGE(PG8_SB(1, 0), cB + kstep, voffB); PG8_STAGE(PG8_SA(1, 0), cA + kstep, voffA); PG8_STAGE(PG8_SB(1, 1), cB + hstep + kstep, voffB);
    PG8_WAIT_V(6); PG8_BAR;
    for (;;) {
        const bool has_next = S.next(ui + 1, nxt);
        const char* nA = cA; const char* nB = cB;
        if (has_next) PG8_PTRS(nxt, nA, nB);
        for (int t = 0; t < nt; t += 2) {
            const bool last = (t == nt - 2);
            const char* a1 = cA + (size_t)(t + 1) * kstep;
            const char* a2 = last ? nA : cA + (size_t)(t + 2) * kstep; const char* b2 = last ? nB : cB + (size_t)(t + 2) * kstep;
            const char* a3 = a2 + kstep; const char* b3 = b2 + kstep;
            PG8_LDB(B0, 0, 0); PG8_SCHED; PG8_LDA(At, 0, 0); PG8_STAGE(PG8_SA(1, 1), a1 + hstep, voffA);
            PG8_WAIT_L(8); PG8_BAR; PG8_WAIT_L(0); PG8_MMA(0, 0, At, B0); PG8_BAR; PG8_SCHED;
            PG8_LDB(B1, 0, 1); PG8_STAGE(PG8_SB(0, 0), b2, voffB);
            PG8_BAR; PG8_WAIT_L(0); PG8_MMA(0, 1, At, B1); PG8_BAR;
            PG8_LDA(At, 0, 1); PG8_STAGE(PG8_SA(0, 0), a2, voffA);
            PG8_BAR; PG8_WAIT_L(0); PG8_MMA(1, 0, At, B0); PG8_BAR; PG8_SCHED;
            PG8_STAGE(PG8_SB(0, 1), b2 + hstep, voffB);
            PG8_WAIT_V(6); PG8_BAR; PG8_MMA(1, 1, At, B1); PG8_BAR;
            PG8_LDB(B0, 1, 0); PG8_SCHED; PG8_LDA(At, 1, 0); PG8_STAGE(PG8_SA(0, 1), a2 + hstep, voffA);
            PG8_WAIT_L(8); PG8_BAR; PG8_WAIT_L(0); PG8_MMA(0, 0, At, B0); PG8_BAR; PG8_SCHED;
            PG8_LDB(B1, 1, 1); PG8_STAGE(PG8_SB(1, 0), b3, voffB);
            PG8_BAR; PG8_WAIT_L(0); PG8_MMA(0, 1, At, B1); PG8_BAR;
            PG8_LDA(At, 1, 1); PG8_STAGE(PG8_SA(1, 0), a3, voffA);
            PG8_BAR; PG8_WAIT_L(0); PG8_MMA(1, 0, At, B0); PG8_BAR; PG8_SCHED;
            PG8_STAGE(PG8_SB(1, 1), b3 + hstep, voffB);
            PG8_WAIT_V(6); PG8_BAR; PG8_MMA(1, 1, At, B1); PG8_BAR;
        }
        E(acc, cur, wr, wc, fr, fq);
        if (!has_next) break;
#pragma unroll
        for (int a = 0; a < 2; ++a)
#pragma unroll
            for (int b = 0; b < 2; ++b)
#pragma unroll
                for (int m = 0; m < 4; ++m)
#pragma unroll
                    for (int n = 0; n < 2; ++n) acc[a][b][m][n] = (f32x4){0.f, 0.f, 0.f, 0.f};
        cur = nxt; cA = nA; cB = nB; ++ui;
    }
    PG8_WAIT_V(0);
    if (wr == 0) PG8_BAR;
    PG8_BAR;
#undef PG8_SA
#undef PG8_SB
#undef PG8_STAGE
#undef PG8_LDA
#undef PG8_LDB
#undef PG8_MMA
#undef PG8_WAIT_V
#undef PG8_WAIT_L
#undef PG8_BAR
#undef PG8_SCHED
#undef PG8_PTRS
}

DI void store_bf16_tile(const f32x4 (&acc)[2][2][4][2], u16* base, size_t ldc, int row0, int col0) {
#pragma unroll
    for (int ai = 0; ai < 2; ++ai)
#pragma unroll
        for (int m = 0; m < 4; ++m) { u16* rowp = base + (size_t)(row0 + ai * HALF + m * 16) * ldc + col0;
#pragma unroll
            for (int bj = 0; bj < 2; ++bj) { const f32x4 v0 = acc[ai][bj][m][0], v1 = acc[ai][bj][m][1];
                u32x4 w; w.x = pk2(v0[0], v0[1]); w.y = pk2(v0[2], v0[3]); w.z = pk2(v1[0], v1[1]); w.w = pk2(v1[2], v1[3]);
                *(u32x4*)(rowp + bj * HALF) = w; } }
}
struct EpiProj {
    u16* projn; float* loga; u16* projt; const float* b_a;
    DI void operator()(const f32x4 (&acc)[2][2][4][2], const Unit& u, int wr, int wc, int fr, int fq) const {
        if (u.pn < 9) store_bf16_tile(acc, projn, LDN, u.pm * BM + wr * 64 + fr, u.pn * BM + wc * 32 + 8 * fq);
        else if (u.pn >= 10) store_bf16_tile(acc, projt, MTOK, (u.pn - 10) * BM + wr * 64 + fr, u.pm * BM + wc * 32 + 8 * fq);
        else {
            const int row0 = u.pm * BM + wr * 64 + fr, col0 = wc * 32 + 8 * fq;
#pragma unroll
            for (int bj = 0; bj < 2; ++bj)
#pragma unroll
                for (int n = 0; n < 2; ++n) { const int col = col0 + bj * HALF + 4 * n; const f32x4 bv = *(const f32x4*)(b_a + col);
#pragma unroll
                    for (int ai = 0; ai < 2; ++ai)
#pragma unroll
                        for (int m = 0; m < 4; ++m) { const f32x4 v = acc[ai][bj][m][n] + bv; f32x4 o;
#pragma unroll
                            for (int j = 0; j < 4; ++j) o[j] = logsig_f(v[j]) * 0.0625f;
                            *(f32x4*)(loga + (size_t)(row0 + ai * HALF + m * 16) * 256 + col) = o; } }
        }
    }
};
struct EpiOut {
    u16* y;
    DI void operator()(const f32x4 (&acc)[2][2][4][2], const Unit& u, int wr, int wc, int fr, int fq) const {
        store_bf16_tile(acc, y, DM, u.pm * BM + wr * 64 + fr, u.pn * BM + wc * 32 + 8 * fq);
    }
};
}

DI void tr_item(const float* W, int ldw, int srccol0, float scale, u16* WT, int k0, LAS float* scr, int lane) {
#pragma unroll 8
    for (int i = 0; i < 32; ++i) { const int kk = 2 * i + (lane >> 5); scr[kk * 33 + (lane & 31)] = W[(size_t)(k0 + kk) * ldw + srccol0 + (lane & 31)]; }
    asm volatile("s_waitcnt lgkmcnt(0)" ::: "memory");
    const int c = lane & 7;
#pragma unroll
    for (int j = 0; j < 4; ++j) { const int n = (lane >> 3) + 8 * j; const LAS float* s = scr + (8 * c) * 33 + n;
        u32x4 o; o.x = pk2(s[0 * 33] * scale, s[1 * 33] * scale); o.y = pk2(s[2 * 33] * scale, s[3 * 33] * scale); o.z = pk2(s[4 * 33] * scale, s[5 * 33] * scale); o.w = pk2(s[6 * 33] * scale, s[7 * 33] * scale);
        *(u32x4*)(WT + (size_t)n * 1024 + k0 + 8 * c) = o; }
    asm volatile("s_waitcnt lgkmcnt(0)" ::: "memory");
}
DI bool bt_src(int n0, int& src, float& scale) {
    scale = 1.f;
    if (n0 < 256) { src = n0; scale = 0.125f; return true; }
    if (n0 < 512) { src = n0; return true; }
    if (n0 < 1024) { src = 1024 + (n0 - 512); return true; }
    if (n0 < 1280) { src = 1552 + (n0 - 1024); scale = 0.125f; return true; }
    if (n0 < 1536) { src = 1808 + (n0 - 1280); return true; }
    if (n0 < 1792) { src = 2320 + (n0 - 1536); return true; }
    if (n0 < 2048) { src = 2576 + (n0 - 1792); scale = 0.125f; return true; }
    if (n0 < 2304) { src = 2832 + (n0 - 2048); return true; }
    if (n0 < 2560) { src = 0; return false; }
    if (n0 < 2816) { src = 256 + (n0 - 2560); return true; }
    if (n0 < 3328) { src = 512 + (n0 - 2816); return true; }
    src = 2064 + (n0 - 3328); return true;
}
DI void prologue(const Params& p, LAS unsigned char* lds) {
    const int tid = otid(), lane = tid & 63, wave = tid >> 6;
    const int gw = blockIdx.x * 8 + wave, NGW = gridDim.x * 8;
    const size_t gt = (size_t)blockIdx.x * 512 + tid, NGT = (size_t)gridDim.x * 512;
    u16* bt = (u16*)(p.ws + WS_BT); u16* bo = (u16*)(p.ws + WS_BO);
    LAS float* scr = (LAS float*)(lds + wave * 8448);
    constexpr int I_IN = DEPTH * 112 * 16, I_OUT = DEPTH * 32 * 16;
    for (int it = gw; it < I_IN + I_OUT; it += NGW) {
        if (it < I_IN) { const int l = it / (112 * 16), r = it % (112 * 16), nb = r / 16, kb = r % 16; int src; float sc;
            if (bt_src(nb * 32, src, sc)) tr_item(p.w_in + (size_t)l * DM * DIN, DIN, src, sc, bt + ((size_t)l * NBT + nb * 32) * 1024, kb * 64, scr, lane); }
        else { const int r0 = it - I_IN, l = r0 / (32 * 16), r = r0 % (32 * 16), nb = r / 16, kb = r % 16;
            tr_item(p.w_out + (size_t)l * DM * DM, DM, nb * 32, 1.f, bo + ((size_t)l * 1024 + nb * 32) * 1024, kb * 64, scr, lane); }
    }
    for (size_t g = gt; g < (size_t)DEPTH * 256 * 128; g += NGT) {
        const int l = (int)(g >> 15), c = (int)(g >> 7) & 255, k = ((int)g & 127) * 8;
        float w2[16];
#pragma unroll
        for (int r = 0; r < 16; ++r) w2[r] = p.w_a2[((size_t)l * 16 + r) * 256 + c];
        float o[8];
#pragma unroll
        for (int kk = 0; kk < 8; ++kk) { const float* wr_ = p.w_in + ((size_t)l * DM + k + kk) * DIN + 1536; float a = 0.f;
#pragma unroll
            for (int r = 0; r < 16; r += 4) { const f32x4 v = *(const f32x4*)(wr_ + r); a += v[0] * w2[r] + v[1] * w2[r + 1] + v[2] * w2[r + 2] + v[3] * w2[r + 3]; }
            o[kk] = a; }
        u32x4 w; w.x = pk2(o[0], o[1]); w.y = pk2(o[2], o[3]); w.z = pk2(o[4], o[5]); w.w = pk2(o[6], o[7]);
        *(u32x4*)(bt + ((size_t)l * NBT + 2304 + c) * 1024 + k) = w;
    }
    { u16* xb = (u16*)(p.ws + WS_XB);
      for (size_t g = gt; g < (size_t)MTOK * DM / 8; g += 4 * NGT) { f32x4 a[4], b[4];
#pragma unroll
          for (int j = 0; j < 4; ++j) { a[j] = *(const f32x4*)(p.x + (g + j * NGT) * 8); b[j] = *(const f32x4*)(p.x + (g + j * NGT) * 8 + 4); }
#pragma unroll
          for (int j = 0; j < 4; ++j) { u32x4 w; w.x = pk2(a[j][0], a[j][1]); w.y = pk2(a[j][2], a[j][3]); w.z = pk2(b[j][0], b[j][1]); w.w = pk2(b[j][2], b[j][3]); *(u32x4*)(xb + (g + j * NGT) * 8) = w; } } }
    { u16* km = (u16*)(p.ws + WS_KM); u16* vmt = (u16*)(p.ws + WS_VMT); const int r = lane & 31, h = lane >> 5;
      for (int it = gw; it < DEPTH * NB * 8 * 16; it += NGW) {
          const int nt = it & 15, mt = (it >> 4) & 7, b = (it >> 7) & 1, l = it >> 8;
          const float* arow = p.mem + ((size_t)b * NMEM + mt * 32 + r) * DM + 8 * h;
          const float* bcol = p.w_mkv + (size_t)l * DM * 512 + (size_t)(8 * h) * 512 + nt * 32 + r;
          f32x16 acc = zero16();
#pragma unroll 4
          for (int s = 0; s < 64; ++s) {
              const f32x4 a0 = *(const f32x4*)(arow + 16 * s), a1 = *(const f32x4*)(arow + 16 * s + 4);
              float bv[8];
#pragma unroll
              for (int j = 0; j < 8; ++j) bv[j] = bcol[(size_t)(16 * s + j) * 512];
              acc = MFMA32(pack8(a0[0], a0[1], a0[2], a0[3], a1[0], a1[1], a1[2], a1[3]), pack8(bv[0], bv[1], bv[2], bv[3], bv[4], bv[5], bv[6], bv[7]), acc);
          }
          const int n = nt * 32 + r;
#pragma unroll
          for (int i = 0; i < 16; ++i) { const int m = mt * 32 + crow(i, h); const u16 v = (u16)(pk2(acc[i], 0.f) & 0xffffu);
              if (n < 256) km[((((size_t)l * NB + b) * 4 + (n >> 6)) * 256 + m) * 64 + (n & 63)] = v;
              else { const int n2 = n - 256; vmt[((((size_t)l * NB + b) * 4 + (n2 >> 6)) * 64 + (n2 & 63)) * 256 + m] = v; } }
      } }
}

DI void gla_cumsum(const float* loga, int chunk, LAS float* G) {
    const int tid = otid(), col = tid & 255, half = tid >> 8;
    const float* src = loga + ((size_t)chunk * 64 + 32 * half) * 256 + col;
    float v[32];
#pragma unroll
    for (int t = 0; t < 32; ++t) v[t] = src[(size_t)t * 256];
#pragma unroll
    for (int t = 1; t < 32; ++t) v[t] += v[t - 1];
    LAS float* tot = G + 64 * GS;
    if (half == 0) tot[col] = v[31];
    __syncthreads();
    const float off = half ? tot[col] : 0.f;
#pragma unroll
    for (int t = 0; t < 32; ++t) G[(32 * half + t) * GS + col] = v[t] + off;
}
DI void gla_u_wave(const Params& p, int chunk, int wave, int lane, const LAS float* G) {
    const int hh = wave >> 1, vh = wave & 1, r = lane & 31, h = lane >> 5;
    const u16* projt = (const u16*)(p.ws + WS_PT); float* U = (float*)(p.ws + WS_U); float* gd = (float*)(p.ws + WS_GD);
    const size_t tok0 = (size_t)chunk * 64;
    f32x16 acc[2][2];
#pragma unroll
    for (int a = 0; a < 2; ++a)
#pragma unroll
        for (int b = 0; b < 2; ++b) acc[a][b] = zero16();
    float glast[2];
#pragma unroll
    for (int cb = 0; cb < 2; ++cb) glast[cb] = G[63 * GS + hh * 64 + 32 * cb + r];
    bf16x8 af[4][2], ktf[4][2];
#pragma unroll
    for (int s = 0; s < 4; ++s) {
#pragma unroll
        for (int rb = 0; rb < 2; ++rb) af[s][rb] = ld_frag(projt + (size_t)(PT_GV + hh * 128 + 64 * vh + 32 * rb + r) * MTOK + tok0 + 16 * s + 8 * h);
#pragma unroll
        for (int cb = 0; cb < 2; ++cb) ktf[s][cb] = ld_frag(projt + (size_t)(PT_GK + hh * 64 + 32 * cb + r) * MTOK + tok0 + 16 * s + 8 * h);
    }
    __builtin_amdgcn_sched_barrier(0);
#pragma unroll
    for (int s = 0; s < 4; ++s) {
        bf16x8 bfr[2];
#pragma unroll
        for (int cb = 0; cb < 2; ++cb) { const int dk = 32 * cb + r; const bf16x8 kt = ktf[s][cb];
            float v[8];
#pragma unroll
            for (int j = 0; j < 8; ++j) { const int t = 16 * s + 8 * h + j; v[j] = bf2f(kt[j]) * __expf(glast[cb] - G[t * GS + hh * 64 + dk]); }
            bfr[cb] = pack8(v[0], v[1], v[2], v[3], v[4], v[5], v[6], v[7]); }
#pragma unroll
        for (int rb = 0; rb < 2; ++rb)
#pragma unroll
            for (int cb = 0; cb < 2; ++cb) acc[rb][cb] = MFMA32(af[s][rb], bfr[cb], acc[rb][cb]);
    }
    float* Ub = U + ((size_t)chunk * 4 + hh) * 8192;
#pragma unroll
    for (int rb = 0; rb < 2; ++rb)
#pragma unroll
        for (int cb = 0; cb < 2; ++cb)
#pragma unroll
            for (int i = 0; i < 16; ++i) Ub[(size_t)(64 * vh + 32 * rb + crow(i, h)) * 64 + 32 * cb + r] = acc[rb][cb][i];
    if (vh == 0) gd[((size_t)chunk * 4 + hh) * 64 + lane] = __expf(G[63 * GS + hh * 64 + lane]);
}
DI void sb_item(const Params& p, int item, int lane) {
    const int head = item & 3, tile = item >> 2, b = tile >> 9, tt = tile & 511, r = lane & 31, h = lane >> 5;
    const u16* projn = (const u16*)(p.ws + WS_PN); const u16* projt = (const u16*)(p.ws + WS_PT); u16* mix = (u16*)(p.ws + WS_MIX);
    const size_t tok0 = (size_t)b * SEQ + (size_t)tt * 32;
    bf16x8 qf[4];
    { const u16* qrow = projn + (tok0 + r) * LDN + PN_SQ + head * 64;
#pragma unroll
      for (int s = 0; s < 4; ++s) qf[s] = ld_frag(qrow + 16 * s + 8 * h); }
    bf16x8 tri[2];
#pragma unroll
    for (int s = 0; s < 2; ++s)
#pragma unroll
        for (int j = 0; j < 8; ++j) tri[s][j] = (16 * s + 8 * (j >> 2) + 4 * h + (j & 3) >= r) ? (short)0x3F80 : (short)0;
    const u16* vt0 = projt + (size_t)(PT_SV + head * 64 + r) * MTOK + (size_t)b * SEQ;
    const u16* vt1 = vt0 + (size_t)32 * MTOK;
    f32x16 o0 = zero16(), o1 = zero16();
    float R = 0.f;
    const int qpos = tt * 32 + r;
    const u16* kbase = projn + ((size_t)b * SEQ + r) * LDN + PN_SK + head * 64 + 8 * h;
    bf16x8 kf[4], va[2], vb[2];
#pragma unroll
    for (int s = 0; s < 4; ++s) kf[s] = ld_frag(kbase + (size_t)tt * 32 * LDN + 16 * s);
#pragma unroll
    for (int s = 0; s < 2; ++s) { va[s] = ld_frag_perm(vt0 + tt * 32 + 16 * s, h); vb[s] = ld_frag_perm(vt1 + tt * 32 + 16 * s, h); }
    for (int kb = tt;; --kb) {
        const int kn = kb > 0 ? kb - 1 : 0;
        bf16x8 nk[4], na[2], nb[2];
#pragma unroll
        for (int s = 0; s < 4; ++s) nk[s] = ld_frag(kbase + (size_t)kn * 32 * LDN + 16 * s);
#pragma unroll
        for (int s = 0; s < 2; ++s) { na[s] = ld_frag_perm(vt0 + kn * 32 + 16 * s, h); nb[s] = ld_frag_perm(vt1 + kn * 32 + 16 * s, h); }
        __builtin_amdgcn_sched_barrier(0);
        f32x16 z = zero16();
#pragma unroll
        for (int s = 0; s < 4; ++s) z = MFMA32(kf[s], qf[s], z);
        const bool diag = (kb == tt);
        f32x16 sp;
#pragma unroll
        for (int i = 0; i < 16; ++i) { const bool ok = !diag || (kb * 32 + crow(i, h) < qpos); sp[i] = ok ? softplus_f(z[i]) : 0.f; }
        f32x16 tm = zero16();
#pragma unroll
        for (int s = 0; s < 2; ++s) tm = MFMA32(tri[s], PACK_STEP(sp, s), tm);
        f32x16 pw;
#pragma unroll
        for (int i = 0; i < 16; ++i) { const bool ok = !diag || (kb * 32 + crow(i, h) < qpos); pw[i] = ok ? __expf(z[i] - tm[i] - R) : 0.f; }
#pragma unroll
        for (int s = 0; s < 2; ++s) { const bf16x8 pb = PACK_STEP(pw, s);
            o0 = MFMA32(va[s], pb, o0);
            o1 = MFMA32(vb[s], pb, o1); }
        R += __shfl(tm[0], r);
        if (kb == 0 || __all(R > SB_THR)) break;
#pragma unroll
        for (int s = 0; s < 4; ++s) kf[s] = nk[s];
#pragma unroll
        for (int s = 0; s < 2; ++s) { va[s] = na[s]; vb[s] = nb[s]; }
    }
    const u16* grow = projn + (tok0 + r) * LDN + PN_SG + head * 64;
    u16* mrow = mix + (tok0 + r) * DM + 512 + head * 64;
#pragma unroll
    for (int db = 0; db < 2; ++db)
#pragma unroll
        for (int g = 0; g < 4; ++g) { const int d = 32 * db + 8 * g + 4 * h; const s16x4 gv = *(const s16x4*)(grow + d);
            float o[4];
#pragma unroll
            for (int e = 0; e < 4; ++e) o[e] = (db ? o1[4 * g + e] : o0[4 * g + e]) * silu_f(bf2f(gv[e]));
            u32x2 w; w.x = pk2(o[0], o[1]); w.y = pk2(o[2], o[3]); *(u32x2*)(mrow + d) = w; }
}
DI void mem_item(const Params& p, int l, int item, int lane) {
    const int head = item & 3, tile = item >> 2, b = tile >> 9, tt = tile & 511, r = lane & 31, h = lane >> 5;
    const u16* projn = (const u16*)(p.ws + WS_PN); u16* mix = (u16*)(p.ws + WS_MIX);
    const u16* km = (const u16*)(p.ws + WS_KM) + (((size_t)l * NB + b) * 4 + head) * 256 * 64;
    const u16* vmt = (const u16*)(p.ws + WS_VMT) + (((size_t)l * NB + b) * 4 + head) * 64 * 256;
    const size_t tok0 = (size_t)b * SEQ + (size_t)tt * 32;
    bf16x8 qf[4];
    { const u16* qrow = projn + (tok0 + r) * LDN + PN_MQ + head * 64;
#pragma unroll
      for (int s = 0; s < 4; ++s) qf[s] = ld_frag(qrow + 16 * s + 8 * h); }
    float mx = -3.0e38f;
    const u16* kmr = km + (size_t)r * 64 + 8 * h;
    { bf16x8 kf[4];
#pragma unroll
      for (int s = 0; s < 4; ++s) kf[s] = ld_frag(kmr + 16 * s);
      for (int mb = 0; mb < 8; ++mb) { const int mn = mb < 7 ? mb + 1 : 7; bf16x8 nk[4];
#pragma unroll
        for (int s = 0; s < 4; ++s) nk[s] = ld_frag(kmr + (size_t)mn * 32 * 64 + 16 * s);
        __builtin_amdgcn_sched_barrier(0);
        f32x16 z = zero16();
#pragma unroll
        for (int s = 0; s < 4; ++s) z = MFMA32(kf[s], qf[s], z);
#pragma unroll
        for (int i = 0; i < 16; ++i) mx = fmaxf(mx, z[i]);
#pragma unroll
        for (int s = 0; s < 4; ++s) kf[s] = nk[s]; } }
    mx = fmaxf(mx, __shfl_xor(mx, 32));
    f32x16 o0 = zero16(), o1 = zero16(); float sum = 0.f;
    { bf16x8 kf[4], va[2], vb[2];
#pragma unroll
      for (int s = 0; s < 4; ++s) kf[s] = ld_frag(kmr + 16 * s);
#pragma unroll
      for (int s = 0; s < 2; ++s) { va[s] = ld_frag_perm(vmt + (size_t)r * 256 + 16 * s, h); vb[s] = ld_frag_perm(vmt + (size_t)(32 + r) * 256 + 16 * s, h); }
      for (int mb = 0; mb < 8; ++mb) { const int mn = mb < 7 ? mb + 1 : 7; bf16x8 nk[4], na[2], nb[2];
#pragma unroll
        for (int s = 0; s < 4; ++s) nk[s] = ld_frag(kmr + (size_t)mn * 32 * 64 + 16 * s);
#pragma unroll
        for (int s = 0; s < 2; ++s) { na[s] = ld_frag_perm(vmt + (size_t)r * 256 + mn * 32 + 16 * s, h); nb[s] = ld_frag_perm(vmt + (size_t)(32 + r) * 256 + mn * 32 + 16 * s, h); }
        __builtin_amdgcn_sched_barrier(0);
        f32x16 z = zero16();
#pragma unroll
        for (int s = 0; s < 4; ++s) z = MFMA32(kf[s], qf[s], z);
        f32x16 pw;
#pragma unroll
        for (int i = 0; i < 16; ++i) { pw[i] = __expf(z[i] - mx); sum += pw[i]; }
#pragma unroll
        for (int s = 0; s < 2; ++s) { const bf16x8 pb = PACK_STEP(pw, s);
            o0 = MFMA32(va[s], pb, o0);
            o1 = MFMA32(vb[s], pb, o1); }
#pragma unroll
        for (int s = 0; s < 4; ++s) kf[s] = nk[s];
#pragma unroll
        for (int s = 0; s < 2; ++s) { va[s] = na[s]; vb[s] = nb[s]; } } }
    sum += __shfl_xor(sum, 32);
    const float inv = 1.f / sum;
    const u16* grow = projn + (tok0 + r) * LDN + PN_MG + head * 64;
    u16* mrow = mix + (tok0 + r) * DM + 768 + head * 64;
#pragma unroll
    for (int db = 0; db < 2; ++db)
#pragma unroll
        for (int g = 0; g < 4; ++g) { const int d = 32 * db + 8 * g + 4 * h; const s16x4 gv = *(const s16x4*)(grow + d);
            float o[4];
#pragma unroll
            for (int e = 0; e < 4; ++e) o[e] = (db ? o1[4 * g + e] : o0[4 * g + e]) * inv * silu_f(bf2f(gv[e]));
            u32x2 w; w.x = pk2(o[0], o[1]); w.y = pk2(o[2], o[3]); *(u32x2*)(mrow + d) = w; }
}
DI void gla_scan(const Params& p) {
    const int tid = otid(); if (tid >= 256) return;
    const int e = blockIdx.x * 256 + tid; if (e >= 65536) return;
    const float* U = (const float*)(p.ws + WS_U); const float* gd = (const float*)(p.ws + WS_GD); u16* Sb = (u16*)(p.ws + WS_SB);
    const int bh = e >> 13, b = bh >> 2, hh = bh & 3, idx = e & 8191, dk = idx & 63;
    float s = 0.f;
    for (int n0 = 0; n0 < 256; n0 += 16) {
        float u[16], g[16];
#pragma unroll
        for (int j = 0; j < 16; ++j) { const size_t base = ((size_t)(b * 256 + n0 + j)) * 4 + hh; u[j] = U[base * 8192 + idx]; g[j] = gd[base * 64 + dk]; }
#pragma unroll
        for (int j = 0; j < 16; ++j) { const size_t base = ((size_t)(b * 256 + n0 + j)) * 4 + hh; Sb[base * 8192 + idx] = (u16)(pk2(s, 0.f) & 0xffffu); s = g[j] * s + u[j]; }
    }
}
DI void gla_out_wave(const Params& p, int l, int chunk, int wave, int lane, const LAS float* G) {
    const int hh = wave >> 1, ih = wave & 1, r = lane & 31, h = lane >> 5;
    const u16* projn = (const u16*)(p.ws + WS_PN); const u16* projt = (const u16*)(p.ws + WS_PT); u16* mix = (u16*)(p.ws + WS_MIX);
    const size_t tok0 = (size_t)chunk * 64;
    const int ti = 32 * ih + r;
    const u16* Sbf = (const u16*)(p.ws + WS_SB) + ((size_t)chunk * 4 + hh) * 8192;
    const u16* vrow = projt + (size_t)(PT_GV + hh * 128 + r) * MTOK + tok0;
    bf16x8 qr[4], kr[2][4], sf0[2][4], vf0[2][2][2];
    { const u16* qrow = projn + (tok0 + ti) * LDN + PN_GQ + hh * 64 + 8 * h;
#pragma unroll
      for (int s = 0; s < 4; ++s) qr[s] = ld_frag(qrow + 16 * s); }
#pragma unroll
    for (int jb = 0; jb < 2; ++jb)
#pragma unroll
        for (int s = 0; s < 4; ++s) kr[jb][s] = ld_frag(projn + (tok0 + 32 * jb + r) * LDN + PN_GK + hh * 64 + 16 * s + 8 * h);
#pragma unroll
    for (int rb = 0; rb < 2; ++rb) {
#pragma unroll
        for (int s = 0; s < 4; ++s) sf0[rb][s] = ld_frag(Sbf + (size_t)(32 * rb + r) * 64 + 16 * s + 8 * h);
#pragma unroll
        for (int jb = 0; jb < 2; ++jb)
#pragma unroll
            for (int s = 0; s < 2; ++s) vf0[rb][jb][s] = ld_frag_perm(vrow + (size_t)(32 * rb) * MTOK + 32 * jb + 16 * s, h);
    }
    __builtin_amdgcn_sched_barrier(0);
    bf16x8 qf[4];
#pragma unroll
    for (int s = 0; s < 4; ++s) { const bf16x8 q = qr[s]; const LAS float* gp = G + ti * GS + hh * 64 + 16 * s + 8 * h;
        const f32x4 g0 = *(const LAS f32x4*)gp, g1 = *(const LAS f32x4*)(gp + 4);
        qf[s] = pack8(bf2f(q[0]) * __expf(g0[0]), bf2f(q[1]) * __expf(g0[1]), bf2f(q[2]) * __expf(g0[2]), bf2f(q[3]) * __expf(g0[3]),
                      bf2f(q[4]) * __expf(g1[0]), bf2f(q[5]) * __expf(g1[1]), bf2f(q[6]) * __expf(g1[2]), bf2f(q[7]) * __expf(g1[3])); }
    bf16x8 pb[2][2];
#pragma unroll
    for (int jb = 0; jb < 2; ++jb) {
        f32x16 am = zero16();
        const int tj = 32 * jb + r;
#pragma unroll
        for (int s = 0; s < 4; ++s) { const bf16x8 k = kr[jb][s]; const LAS float* gp = G + tj * GS + hh * 64 + 16 * s + 8 * h;
            const f32x4 g0 = *(const LAS f32x4*)gp, g1 = *(const LAS f32x4*)(gp + 4);
            const bf16x8 kf = pack8(bf2f(k[0]) * __expf(-g0[0]), bf2f(k[1]) * __expf(-g0[1]), bf2f(k[2]) * __expf(-g0[2]), bf2f(k[3]) * __expf(-g0[3]),
                                    bf2f(k[4]) * __expf(-g1[0]), bf2f(k[5]) * __expf(-g1[1]), bf2f(k[6]) * __expf(-g1[2]), bf2f(k[7]) * __expf(-g1[3]));
            am = MFMA32(kf, qf[s], am); }
#pragma unroll
        for (int i = 0; i < 16; ++i) am[i] = (32 * jb + crow(i, h) <= ti) ? am[i] : 0.f;
#pragma unroll
        for (int s = 0; s < 2; ++s) pb[jb][s] = PACK_STEP(am, s);
    }
    bf16x8 sf1[2][4], vf1[2][2][2];
#pragma unroll
    for (int rb = 0; rb < 2; ++rb) {
#pragma unroll
        for (int s = 0; s < 4; ++s) sf1[rb][s] = ld_frag(Sbf + (size_t)(64 + 32 * rb + r) * 64 + 16 * s + 8 * h);
#pragma unroll
        for (int jb = 0; jb < 2; ++jb)
#pragma unroll
            for (int s = 0; s < 2; ++s) vf1[rb][jb][s] = ld_frag_perm(vrow + (size_t)(64 + 32 * rb) * MTOK + 32 * jb + 16 * s, h);
    }
    __builtin_amdgcn_sched_barrier(0);
    f32x16 o[4];
#pragma unroll
    for (int rb = 0; rb < 4; ++rb) o[rb] = zero16();
#pragma unroll
    for (int rb = 0; rb < 2; ++rb) {
#pragma unroll
        for (int s = 0; s < 4; ++s) o[rb] = MFMA32(sf0[rb][s], qf[s], o[rb]);
#pragma unroll
        for (int jb = 0; jb < 2; ++jb)
#pragma unroll
            for (int s = 0; s < 2; ++s) o[rb] = MFMA32(vf0[rb][jb][s], pb[jb][s], o[rb]);
    }
#pragma unroll
    for (int rb = 0; rb < 2; ++rb) {
#pragma unroll
        for (int s = 0; s < 4; ++s) o[2 + rb] = MFMA32(sf1[rb][s], qf[s], o[2 + rb]);
#pragma unroll
        for (int jb = 0; jb < 2; ++jb)
#pragma unroll
            for (int s = 0; s < 2; ++s) o[2 + rb] = MFMA32(vf1[rb][jb][s], pb[jb][s], o[2 + rb]);
    }
    float ss = 0.f;
#pragma unroll
    for (int rb = 0; rb < 4; ++rb)
#pragma unroll
        for (int i = 0; i < 16; ++i) ss += o[rb][i] * o[rb][i];
    ss += __shfl_xor(ss, 32);
    const float rinv = rsqrtf(ss * (1.f / 128.f) + RMS_EPS);
    const u16* grow = projn + (tok0 + ti) * LDN + PN_GG + hh * 128;
    u16* mrow = mix + (tok0 + ti) * DM + hh * 128;
    const float* nw = p.gnw + (size_t)l * 128;
#pragma unroll
    for (int rb = 0; rb < 4; ++rb)
#pragma unroll
        for (int g = 0; g < 4; ++g) { const int dv = 32 * rb + 8 * g + 4 * h; const s16x4 gv = *(const s16x4*)(grow + dv); const f32x4 wv = *(const f32x4*)(nw + dv);
            float ov[4];
#pragma unroll
            for (int e = 0; e < 4; ++e) ov[e] = o[rb][4 * g + e] * rinv * wv[e] * silu_f(bf2f(gv[e]));
            u32x2 w; w.x = pk2(ov[0], ov[1]); w.y = pk2(ov[2], ov[3]); *(u32x2*)(mrow + dv) = w; }
}
DI void ln_phase(const Params& p, int l) {
    const int tid = otid(), lane = tid & 63, gw = blockIdx.x * 8 + (tid >> 6), NGW = gridDim.x * 8;
    const float* xin = l == 0 ? p.x : p.out; const u16* y = (const u16*)(p.ws + WS_PN); u16* xb = (u16*)(p.ws + WS_XB);
    const float* gam = p.ln_g + (size_t)l * DM; const float* bet = p.ln_b + (size_t)l * DM;
    for (int row = gw; row < MTOK; row += NGW) {
        f32x4 v[4]; float s = 0.f;
#pragma unroll
        for (int j = 0; j < 4; ++j) { const int c = 4 * lane + 256 * j; const f32x4 xv = *(const f32x4*)(xin + (size_t)row * DM + c); const s16x4 yv = *(const s16x4*)(y + (size_t)row * DM + c);
#pragma unroll
            for (int e = 0; e < 4; ++e) { v[j][e] = ALPHA_DN * xv[e] + bf2f(yv[e]); s += v[j][e]; } }
#pragma unroll
        for (int o = 1; o < 64; o <<= 1) s += __shfl_xor(s, o);
        const float mean = s * (1.f / DM); float q = 0.f;
#pragma unroll
        for (int j = 0; j < 4; ++j)
#pragma unroll
            for (int e = 0; e < 4; ++e) { v[j][e] -= mean; q += v[j][e] * v[j][e]; }
#pragma unroll
        for (int o = 1; o < 64; o <<= 1) q += __shfl_xor(q, o);
        const float rstd = rsqrtf(q * (1.f / DM) + LN_EPS);
#pragma unroll
        for (int j = 0; j < 4; ++j) { const int c = 4 * lane + 256 * j; const f32x4 gv = *(const f32x4*)(gam + c), bv = *(const f32x4*)(bet + c); f32x4 ov;
#pragma unroll
            for (int e = 0; e < 4; ++e) ov[e] = v[j][e] * rstd * gv[e] + bv[e];
            *(f32x4*)(p.out + (size_t)row * DM + c) = ov;
            u32x2 w; w.x = pk2(ov[0], ov[1]); w.y = pk2(ov[2], ov[3]); *(u32x2*)(xb + (size_t)row * DM + c) = w; }
    }
}

#define XB_TMO      128
#define XB_XCNT(j)  (256  + 64 * (j))
#define XB_XSUB(j)  (1280 + 64 * (j))
#define XB_XGEN(j)  (2304 + 64 * (j))
#define XB_TOP      3328
#define XB_TOPGEN   3392
#define XCD_BAR_WORDS 3456
#define XB_SPIN_CAP (1u << 18)
DI unsigned xb_ld(unsigned* p)              { return __hip_atomic_load(p, __ATOMIC_RELAXED, __HIP_MEMORY_SCOPE_AGENT); }
DI unsigned xb_add(unsigned* p, unsigned v) { return __hip_atomic_fetch_add(p, v, __ATOMIC_RELAXED, __HIP_MEMORY_SCOPE_AGENT); }
DI unsigned xb_xcc_id() { return (unsigned)__builtin_amdgcn_s_getreg((3 << 11) | 20) & 0xFu; }
#define XB_SPIN(cond, bar) do { unsigned _sp = 0; while (cond) { __builtin_amdgcn_s_sleep(1); \
    if ((++_sp & 255u) == 0u) { if (xb_ld(&(bar)[XB_TMO])) break; if (_sp > XB_SPIN_CAP) { atomicAdd(&(bar)[XB_TMO], 1u); break; } } } } while (0)
struct XcdBarrier { unsigned* bar; unsigned x; volatile LAS unsigned* st; };
DI XcdBarrier xcd_barrier_post(unsigned* bar, volatile LAS unsigned* st) {
    XcdBarrier b; b.bar = bar; b.x = xb_xcc_id(); b.st = st;
    if (threadIdx.x == 0) (void)xb_add(&bar[XB_XCNT(b.x)], 1u);
    return b;
}
DI void xcd_barrier_complete(unsigned* bar, unsigned x, unsigned& nloc, unsigned& nx) {
    const unsigned G = gridDim.x * gridDim.y * gridDim.z;
    unsigned sum, cnt, mine, sp = 0u;
    for (;;) {
        sum = 0u; cnt = 0u; mine = 0u;
#pragma unroll
        for (unsigned j = 0; j < 16; ++j) { const unsigned c = xb_ld(&bar[XB_XCNT(j)]); sum += c; cnt += (c > 0u) ? 1u : 0u; mine = (j == x) ? c : mine; }
        if (sum == G) break;
        __builtin_amdgcn_s_sleep(1);
        if ((++sp & 255u) == 0u) { if (xb_ld(&bar[XB_TMO])) break; if (sp > XB_SPIN_CAP) { atomicAdd(&bar[XB_TMO], 1u); break; } }
    }
    nloc = mine > 0u ? mine : 1u; nx = cnt > 0u ? cnt : 1u;
}
DI void xcd_barrier(const XcdBarrier& b) {
    asm volatile("s_waitcnt vmcnt(0)" ::: "memory");
    __syncthreads();
    if (threadIdx.x == 0) {
        unsigned* bar = b.bar;
        __builtin_amdgcn_s_waitcnt(0);
        unsigned nloc = b.st[0], nx = b.st[1];
        if (nloc == 0u) { xcd_barrier_complete(bar, b.x, nloc, nx); b.st[0] = nloc; b.st[1] = nx; }
        const unsigned old = xb_add(&bar[XB_XSUB(b.x)], 1u);
        const unsigned gen = old / nloc;
        if (old + 1u == (gen + 1u) * nloc) {
            __builtin_amdgcn_fence(__ATOMIC_RELEASE, "agent");
            asm volatile("s_waitcnt vmcnt(0)" ::: "memory");
            const unsigned og = xb_add(&bar[XB_TOP], 1u);
            const unsigned tg = og / nx;
            if (og + 1u == (tg + 1u) * nx) xb_add(&bar[XB_TOPGEN], 1u);
            else XB_SPIN(xb_ld(&bar[XB_TOPGEN]) == tg, bar);
            __builtin_amdgcn_fence(__ATOMIC_ACQUIRE, "agent");
            xb_add(&bar[XB_XGEN(b.x)], 1u);
            asm volatile("s_waitcnt vmcnt(0)" ::: "memory");
        } else {
            XB_SPIN(xb_ld(&bar[XB_XGEN(b.x)]) == gen, bar);
            __builtin_amdgcn_fence(__ATOMIC_ACQUIRE, "agent");
            asm volatile("s_waitcnt vmcnt(0)" ::: "memory");
        }
    }
    __syncthreads();
}

__global__ __launch_bounds__(512, 2) void fwd_megakernel(Params p) {
    extern __shared__ __attribute__((aligned(16))) unsigned char shm[];
    cg::grid_group grid = cg::this_grid();
    LAS unsigned char* lds = (LAS unsigned char*)shm;
    volatile LAS unsigned* xbw = (volatile LAS unsigned*)(lds + 131072);
    if (threadIdx.x == 0) { xbw[0] = 0u; xbw[1] = 0u; }
    __syncthreads();
    const XcdBarrier xb = xcd_barrier_post((unsigned*)(p.ws + WS_BAR), xbw);
    prologue(p, lds);
    grid.sync();
#pragma unroll 1
    for (int l = 0; l < DEPTH; ++l) {
#pragma unroll 1
        for (int rep = 0; rep < REP_A; ++rep)
        { pg8::Gemm g{(const u16*)(p.ws + WS_XB), (const u16*)(p.ws + WS_BT) + (size_t)l * NBT * 1024, MTOK, NBT, DM, 10};
          pg8::StaticOrder S; S.init(MTOK, NBT, (int)gridDim.x, (int)blockIdx.x);
          pg8::EpiProj E{(u16*)(p.ws + WS_PN), (float*)(p.ws + WS_LA), (u16*)(p.ws + WS_PT), p.b_a + (size_t)l * 256};
          pg8::gemm_phase<pg8::EpiProj>(lds, g, S, E); }
        xcd_barrier(xb);
#pragma unroll 1
        for (int rep = 0; rep < EXTRA_SYNC; ++rep) xcd_barrier(xb);
#pragma unroll 1
        for (int rep = 0; rep < REP_B1; ++rep)
        { const int tid = otid(), lane = tid & 63, wave = tid >> 6;
          for (int c = blockIdx.x; c < 512; c += gridDim.x) {
            gla_cumsum((const float*)(p.ws + WS_LA), c, (LAS float*)lds);
            __syncthreads();
            gla_u_wave(p, c, wave, lane, (const LAS float*)lds);
            __syncthreads();
          } }
#pragma unroll 1
        for (int rep = 0; rep < REP_B2; ++rep)
        { const int tid = otid(), lane = tid & 63, gw = blockIdx.x * 8 + (tid >> 6), NGW = gridDim.x * 8;
          for (int it = gw; it < 4096; it += NGW) sb_item(p, it, lane); }
#pragma unroll 1
        for (int rep = 0; rep < REP_B3; ++rep)
        { const int tid = otid(), lane = tid & 63, gw = blockIdx.x * 8 + (tid >> 6), NGW = gridDim.x * 8;
          for (int it = gw; it < 4096; it += NGW) mem_item(p, l, it, lane); }
        xcd_barrier(xb);
#pragma unroll 1
        for (int rep = 0; rep < REP_C; ++rep) gla_scan(p);
        xcd_barrier(xb);
#pragma unroll 1
        for (int rep = 0; rep < REP_D; ++rep)
        { const int tid = otid(), lane = tid & 63, wave = tid >> 6;
          for (int c = blockIdx.x; c < 512; c += gridDim.x) {
            gla_cumsum((const float*)(p.ws + WS_LA), c, (LAS float*)lds);
            __syncthreads();
            gla_out_wave(p, l, c, wave, lane, (const LAS float*)lds);
            __syncthreads();
          } }
        xcd_barrier(xb);
#pragma unroll 1
        for (int rep = 0; rep < REP_E; ++rep)
        { pg8::Gemm g{(const u16*)(p.ws + WS_MIX), (const u16*)(p.ws + WS_BO) + (size_t)l * 1024 * 1024, MTOK, DM, DM, 1 << 30};
          pg8::StaticOrder S; S.init(MTOK, DM, (int)gridDim.x, (int)blockIdx.x);
          pg8::EpiOut E{(u16*)(p.ws + WS_PN)};
          pg8::gemm_phase<pg8::EpiOut>(lds, g, S, E); }
        xcd_barrier(xb);
        ln_phase(p, l);
        xcd_barrier(xb);
    }
}

extern "C" void kernel_launch(void* const* d_in, const int* in_sizes, int n_in, void* d_out, int out_size, void* d_ws, size_t ws_size, hipStream_t stream) {
    static int grid = 0;
    if (grid == 0) {
        if (n_in != 10 || in_sizes[0] != MTOK * DM || out_size != MTOK * DM || ws_size < WS_END) {
            fprintf(stderr, "kernel_launch: unexpected shapes or workspace (n_in %d, ws %zu, need %zu)\n", n_in, ws_size, (size_t)WS_END); grid = -1; return; }
        int dev = 0, cus = 0, per_cu = 0;
        (void)hipGetDevice(&dev);
        (void)hipDeviceGetAttribute(&cus, hipDeviceAttributeMultiprocessorCount, dev);
        if (hipFuncSetAttribute((const void*)fwd_megakernel, hipFuncAttributeMaxDynamicSharedMemorySize, LDS_BYTES) != hipSuccess) { fprintf(stderr, "kernel_launch: hipFuncSetAttribute failed\n"); grid = -1; return; }
        (void)hipOccupancyMaxActiveBlocksPerMultiprocessor(&per_cu, (const void*)fwd_megakernel, 512, LDS_BYTES);
        if (per_cu < 1) { fprintf(stderr, "kernel_launch: occupancy query says %d blocks per CU\n", per_cu); per_cu = 1; }
        (void)hipGetLastError();
        grid = cus;
    }
    if (grid < 0) return;
    if (hipMemsetAsync((unsigned char*)d_ws + WS_BAR, 0, 16384, stream) != hipSuccess) { fprintf(stderr, "kernel_launch: hipMemsetAsync failed\n"); return; }
    Params p{};
    p.x = (const float*)d_in[0]; p.mem = (const float*)d_in[1]; p.w_in = (const float*)d_in[2]; p.w_a2 = (const float*)d_in[3]; p.b_a = (const float*)d_in[4];
    p.gnw = (const float*)d_in[5]; p.w_mkv = (const float*)d_in[6]; p.w_out = (const float*)d_in[7]; p.ln_g = (const float*)d_in[8]; p.ln_b = (const float*)d_in[9];
    p.out = (float*)d_out; p.ws = (unsigned char*)d_ws;
    void* args[] = {&p};
    hipError_t e = hipLaunchCooperativeKernel((const void*)fwd_megakernel, dim3(grid), dim3(512), args, LDS_BYTES, stream);
    if (e != hipSuccess) fprintf(stderr, "cooperative launch failed: %s (grid %d)\n", hipGetErrorString(e), grid);
}
```

```cpp
#include <hip/hip_runtime.h>
#include <hip/hip_cooperative_groups.h>
#include <cstdio>
namespace cg = cooperative_groups;

#define DI __device__ __forceinline__
#define LAS __attribute__((address_space(3)))
typedef unsigned short u16;
typedef short bf16x8 __attribute__((ext_vector_type(8)));
typedef short s16x4 __attribute__((ext_vector_type(4)));
typedef float f32x2 __attribute__((ext_vector_type(2)));
typedef float f32x4 __attribute__((ext_vector_type(4)));
typedef float f32x16 __attribute__((ext_vector_type(16)));
typedef unsigned u32x2 __attribute__((ext_vector_type(2)));
typedef unsigned u32x4 __attribute__((ext_vector_type(4)));
typedef __bf16 bf16x2v __attribute__((ext_vector_type(2)));

constexpr int SEQ = 16384, NB = 2, MTOK = NB * SEQ, DM = 1024, DEPTH = 4, NMEM = 256, DIN = 3088;
constexpr int LDN = 2304;
constexpr int PN_GQ = 0, PN_GK = 256, PN_GG = 512, PN_SQ = 1024, PN_SK = 1280, PN_SG = 1536, PN_MQ = 1792, PN_MG = 2048;
constexpr int NBT = 3584;
constexpr int PT_GK = 0, PT_GV = 256, PT_SV = 768;
constexpr float ALPHA_DN = 1.681792830507429f;
constexpr float LN_EPS = 1e-5f, RMS_EPS = 1e-6f;
constexpr float SB_THR = 40.0f;
constexpr int GS = 260;

constexpr size_t WS_BT = 0;
constexpr size_t WS_BO = WS_BT + (size_t)DEPTH * NBT * 1024 * 2;
constexpr size_t WS_KM = WS_BO + (size_t)DEPTH * 1024 * 1024 * 2;
constexpr size_t WS_VMT = WS_KM + (size_t)DEPTH * NB * 4 * 256 * 64 * 2;
constexpr size_t WS_XB = WS_VMT + (size_t)DEPTH * NB * 4 * 256 * 64 * 2;
constexpr size_t WS_PN = WS_XB + (size_t)MTOK * 1024 * 2;
constexpr size_t WS_LA = WS_PN + (size_t)MTOK * LDN * 2;
constexpr size_t WS_PT = WS_LA + (size_t)MTOK * 256 * 4;
constexpr size_t WS_MIX = WS_PT + (size_t)1024 * MTOK * 2;
constexpr size_t WS_U = WS_MIX + (size_t)MTOK * 1024 * 2;
constexpr size_t WS_GD = WS_U + (size_t)512 * 4 * 128 * 64 * 4;
constexpr size_t WS_SB = WS_GD + (size_t)512 * 4 * 64 * 4;
constexpr size_t WS_BAR = WS_SB + (size_t)512 * 4 * 128 * 64 * 2;
constexpr size_t WS_END = WS_BAR + 16384;
constexpr int LDS_BYTES = 131072 + 64;
#define REP_A 1
#define REP_B1 2
#define REP_B2 1
#define REP_B3 1
#define REP_C 1
#define REP_D 1
#define REP_E 1
#define EXTRA_SYNC 0
#define REP_P 1

struct Params {
    const float *x, *mem, *w_in, *w_a2, *b_a, *gnw, *w_mkv, *w_out, *ln_g, *ln_b;
    float* out; unsigned char* ws;
};

DI unsigned pk2(float a, float b) { f32x2 f = {a, b}; bf16x2v v = __builtin_convertvector(f, bf16x2v); return __builtin_bit_cast(unsigned, v); }
DI float bf2f(short s) { return __uint_as_float(((unsigned)(u16)s) << 16); }
DI int crow(int reg, int h) { return (reg & 3) + 8 * (reg >> 2) + 4 * h; }
#define MFMA32(a, b, c) __builtin_amdgcn_mfma_f32_32x32x16_bf16((a), (b), (c), 0, 0, 0)
DI bf16x8 pack8(float a0, float a1, float a2, float a3, float a4, float a5, float a6, float a7) {
    u32x4 p = {pk2(a0, a1), pk2(a2, a3), pk2(a4, a5), pk2(a6, a7)}; return __builtin_bit_cast(bf16x8, p);
}
#define PACK_STEP(x, s) pack8((x)[8 * (s)], (x)[8 * (s) + 1], (x)[8 * (s) + 2], (x)[8 * (s) + 3], (x)[8 * (s) + 4], (x)[8 * (s) + 5], (x)[8 * (s) + 6], (x)[8 * (s) + 7])
DI bf16x8 ld_frag(const u16* p) { return *(const bf16x8*)p; }
DI bf16x8 ld_frag_perm(const u16* rowp, int h) {
    const s16x4 lo = *(const s16x4*)(rowp + 4 * h), hi = *(const s16x4*)(rowp + 8 + 4 * h);
    return __builtin_shufflevector(lo, hi, 0, 1, 2, 3, 4, 5, 6, 7);
}
DI float softplus_f(float z) { return fmaxf(z, 0.f) + __logf(1.f + __expf(-fabsf(z))); }
DI float logsig_f(float z) { return fminf(z, 0.f) - __logf(1.f + __expf(-fabsf(z))); }
DI float silu_f(float z) { return z / (1.f + __expf(-z)); }
DI f32x16 zero16() { f32x16 z; for (int i = 0; i < 16; ++i) z[i] = 0.f; return z; }
DI int otid() { int t = threadIdx.x; asm volatile("" : "+v"(t)); return t; }

namespace pg8 {
constexpr int BM = 256, BK = 64, HALF = 128, HTB = HALF * BK * 2, NXCD = 8, WGM = 8;
DI int lds_byte(int r, int c) { const int st = (r >> 4) * 2 + (c >> 5), rr = r & 15, cc = c & 31, ob = rr * 64 + cc * 2; return st * 1024 + (ob ^ (((ob >> 9) & 1) << 5)); }
DI void stage_rc(int b, int& R, int& C) { const int st = b / 1024, sb = b % 1024, swz = sb ^ (((sb >> 9) & 1) << 5); R = (st >> 1) * 16 + swz / 64; C = (st & 1) * 32 + (swz % 64) / 2; }
DI int perm32(int rho) { const int n = rho >> 4, i = rho & 15; return 8 * (i >> 2) + 4 * n + (i & 3); }
struct Unit { int pm, pn; };
struct Gemm { const u16* A; const u16* Bt; int M, N, K; int swap_from; };
struct StaticOrder {
    int nM, nN, nwg, G, c;
    DI void init(int M, int N, int G_, int c_) { nM = M / BM; nN = N / BM; nwg = nM * nN; G = G_; c = c_; }
    DI bool next(int i, Unit& u) const {
        const long L = (long)i * G + c; if (L >= nwg) return false;
        int wgid = (int)L; { const int q = nwg / NXCD, r = nwg % NXCD, xcd = wgid % NXCD, off = wgid / NXCD; wgid = (xcd < r ? xcd * (q + 1) : r * (q + 1) + (xcd - r) * q) + off; }
        const int nig = WGM * nN, gid = wgid / nig, fm = gid * WGM, gsz = (nM - fm) < WGM ? (nM - fm) : WGM;
        u.pm = fm + ((wgid % nig) % gsz); u.pn = (wgid % nig) / gsz; return true;
    }
};

template <class Epi, bool ALIGN_EPI, bool SP2>
DI void gemm_phase(LAS unsigned char* lds, const Gemm g, const StaticOrder& S, const Epi& E) {
    const int tid = otid(), wid = __builtin_amdgcn_readfirstlane(tid >> 6), lane = tid & 63, wr = wid >> 2, wc = wid & 3, fr = lane & 15, fq = lane >> 4;
    const int K = g.K, nt = K / BK;
    unsigned voffA[2], voffB[2];
#pragma unroll
    for (int i = 0; i < 2; ++i) { int R, C; stage_rc(tid * 16 + i * 8192, R, C); const int Rb = Epi::PERM ? ((R & ~31) + perm32(R & 31)) : R;
        voffA[i] = (unsigned)(R * K + C) * 2u; voffB[i] = (unsigned)(Rb * K + C) * 2u; }
    const size_t kstep = (size_t)(BK * 2);
    const size_t hstep = (size_t)HALF * K * 2;
    const size_t tstep = 2 * hstep;
    const unsigned ldsw = (unsigned)wid * 1024u;
    const int aoff = lds_byte(wr * 64 + fr, fq * 8), boff = lds_byte(wc * 32 + fr, fq * 8);
#define PG8_SA(b, h) (((b) * 2 + (h)) * HTB)
#define PG8_SB(b, h) ((4 + (b) * 2 + (h)) * HTB)
#define PG8_STAGE(bufoff, gbase, voff) do { _Pragma("unroll") for (int _i = 0; _i < 2; ++_i) \
        __builtin_amdgcn_global_load_lds((const unsigned*)((const char*)(gbase) + (voff)[_i]), (LAS unsigned*)(lds + (bufoff) + ldsw + _i * 8192), 16, 0, 0); } while (0)
#define PG8_LDA(dst, b, h) do { _Pragma("unroll") for (int m = 0; m < 4; ++m) _Pragma("unroll") for (int k = 0; k < 2; ++k) dst[m][k] = *(const LAS bf16x8*)(lds + PG8_SA(b, h) + aoff + m * 2048 + k * 1024); } while (0)
#define PG8_LDB(dst, b, h) do { _Pragma("unroll") for (int n = 0; n < 2; ++n) _Pragma("unroll") for (int k = 0; k < 2; ++k) dst[n][k] = *(const LAS bf16x8*)(lds + PG8_SB(b, h) + boff + n * 2048 + k * 1024); } while (0)
#define PG8_MMA(ai, bj, At, Bt) do { __builtin_amdgcn_s_setprio(1); _Pragma("unroll") for (int m = 0; m < 4; ++m) _Pragma("unroll") for (int n = 0; n < 2; ++n) _Pragma("unroll") for (int k = 0; k < 2; ++k) \
        acc[ai][bj][m][n] = __builtin_amdgcn_mfma_f32_16x16x32_bf16(Bt[n][k], At[m][k], acc[ai][bj][m][n], 0, 0, 0); __builtin_amdgcn_s_setprio(0); } while (0)
#define PG8_WAIT_V(n) asm volatile("s_waitcnt vmcnt(" #n ")" ::: "memory")
#define PG8_WAIT_L(n) asm volatile("s_waitcnt lgkmcnt(" #n ")" ::: "memory")
#define PG8_BAR __builtin_amdgcn_s_barrier()
#define PG8_SCHED __builtin_amdgcn_sched_barrier(0)
#define PG8_PTRS(u, pa, pb) do { const char* _a = (const char*)g.A + (size_t)(u).pm * tstep; const char* _b = (const char*)g.Bt + (size_t)(u).pn * tstep; \
        if ((u).pn >= g.swap_from) { pa = _b; pb = _a; } else { pa = _a; pb = _b; } } while (0)
    Unit cur, nxt; int ui = 0;
    if (!S.next(0, cur)) return;
    f32x4 acc[2][2][4][2];
#pragma unroll
    for (int a = 0; a < 2; ++a)
#pragma unroll
        for (int b = 0; b < 2; ++b)
#pragma unroll
            for (int m = 0; m < 4; ++m)
#pragma unroll
                for (int n = 0; n < 2; ++n) acc[a][b][m][n] = (f32x4){0.f, 0.f, 0.f, 0.f};
    bf16x8 At[4][2], B0[2][2], B1[2][2];
    const char* cA; const char* cB; PG8_PTRS(cur, cA, cB);
    if constexpr (SP2) {
        PG8_STAGE(PG8_SB(0, 0), cB, voffB); PG8_STAGE(PG8_SB(0, 1), cB + hstep, voffB); PG8_STAGE(PG8_SA(0, 0), cA, voffA); PG8_STAGE(PG8_SA(0, 1), cA + hstep, voffA);
        if (wr == 1) PG8_BAR;
        PG8_WAIT_V(2); PG8_BAR;
        PG8_STAGE(PG8_SB(1, 0), cB + kstep, voffB); PG8_STAGE(PG8_SA(1, 0), cA + kstep, voffA); PG8_STAGE(PG8_SB(1, 1), cB + hstep + kstep, voffB);
        PG8_WAIT_V(6); PG8_BAR;
    } else {
        PG8_STAGE(PG8_SB(0, 0), cB, voffB); PG8_STAGE(PG8_SA(0, 0), cA, voffA); PG8_STAGE(PG8_SB(0, 1), cB + hstep, voffB); PG8_STAGE(PG8_SA(0, 1), cA + hstep, voffA);
        if (wr == 1) PG8_BAR;
        PG8_WAIT_V(4); PG8_BAR;
        PG8_STAGE(PG8_SB(1, 0), cB + kstep, voffB); PG8_STAGE(PG8_SA(1, 0), cA + kstep, voffA); PG8_STAGE(PG8_SB(1, 1), cB + hstep + kstep, voffB);
        PG8_WAIT_V(6); PG8_BAR;
    }
    for (;;) {
        const bool has_next = S.next(ui + 1, nxt);
        const char* nA = cA; const char* nB = cB;
        if (has_next) PG8_PTRS(nxt, nA, nB);
        for (int t = 0; t < nt; t += 2) {
            const bool last = (t == nt - 2);
            const char* a1 = cA + (size_t)(t + 1) * kstep;
            const char* a2 = last ? nA : cA + (size_t)(t + 2) * kstep; const char* b2 = last ? nB : cB + (size_t)(t + 2) * kstep;
            const char* a3 = a2 + kstep; const char* b3 = b2 + kstep;
            if constexpr (SP2) {
            PG8_LDB(B0, 0, 0); PG8_LDB(B1, 0, 1); PG8_SCHED; PG8_LDA(At, 0, 0); PG8_STAGE(PG8_SA(1, 1), a1 + hstep, voffA);
            PG8_WAIT_V(8); PG8_WAIT_L(0); PG8_BAR; PG8_MMA(0, 0, At, B0); PG8_MMA(0, 1, At, B1); PG8_BAR; PG8_SCHED;
            PG8_LDA(At, 0, 1); PG8_STAGE(PG8_SB(0, 0), b2, voffB); PG8_STAGE(PG8_SB(0, 1), b2 + hstep, voffB); PG8_STAGE(PG8_SA(0, 0), a2, voffA);
            PG8_WAIT_V(8); PG8_WAIT_L(0); PG8_BAR; PG8_MMA(1, 0, At, B0); PG8_MMA(1, 1, At, B1); PG8_BAR; PG8_SCHED;
            PG8_LDB(B0, 1, 0); PG8_LDB(B1, 1, 1); PG8_SCHED; PG8_LDA(At, 1, 0); PG8_STAGE(PG8_SA(0, 1), a2 + hstep, voffA);
            PG8_WAIT_V(8); PG8_WAIT_L(0); PG8_BAR; PG8_MMA(0, 0, At, B0); PG8_MMA(0, 1, At, B1); PG8_BAR; PG8_SCHED;
            PG8_LDA(At, 1, 1); PG8_STAGE(PG8_SB(1, 0), b3, voffB); PG8_STAGE(PG8_SB(1, 1), b3 + hstep, voffB); PG8_STAGE(PG8_SA(1, 0), a3, voffA);
            PG8_WAIT_V(8); PG8_WAIT_L(0); PG8_BAR; PG8_MMA(1, 0, At, B0); PG8_MMA(1, 1, At, B1); PG8_BAR; PG8_SCHED;
            } else {
            PG8_LDB(B0, 0, 0); PG8_SCHED; PG8_LDA(At, 0, 0); PG8_STAGE(PG8_SA(1, 1), a1 + hstep, voffA);
            PG8_WAIT_L(8); PG8_BAR; PG8_WAIT_L(0); PG8_MMA(0, 0, At, B0); PG8_BAR; PG8_SCHED;
            PG8_LDB(B1, 0, 1); PG8_STAGE(PG8_SB(0, 0), b2, voffB);
            PG8_BAR; PG8_WAIT_L(0); PG8_MMA(0, 1, At, B1); PG8_BAR;
            PG8_LDA(At, 0, 1); PG8_STAGE(PG8_SA(0, 0), a2, voffA);
            PG8_BAR; PG8_WAIT_L(0); PG8_MMA(1, 0, At, B0); PG8_BAR; PG8_SCHED;
            PG8_STAGE(PG8_SB(0, 1), b2 + hstep, voffB);
            PG8_WAIT_V(6); PG8_BAR; PG8_MMA(1, 1, At, B1); PG8_BAR;
            PG8_LDB(B0, 1, 0); PG8_SCHED; PG8_LDA(At, 1, 0); PG8_STAGE(PG8_SA(0, 1), a2 + hstep, voffA);
            PG8_WAIT_L(8); PG8_BAR; PG8_WAIT_L(0); PG8_MMA(0, 0, At, B0); PG8_BAR; PG8_SCHED;
            PG8_LDB(B1, 1, 1); PG8_STAGE(PG8_SB(1, 0), b3, voffB);
            PG8_BAR; PG8_WAIT_L(0); PG8_MMA(0, 1, At, B1); PG8_BAR;
            PG8_LDA(At, 1, 1); PG8_STAGE(PG8_SA(1, 0), a3, voffA);
            PG8_BAR; PG8_WAIT_L(0); PG8_MMA(1, 0, At, B0); PG8_BAR; PG8_SCHED;
            PG8_STAGE(PG8_SB(1, 1), b3 + hstep, voffB);
            PG8_WAIT_V(6); PG8_BAR; PG8_MMA(1, 1, At, B1); PG8_BAR;
            }
        }
        if constexpr (ALIGN_EPI) { if (wr == 0) PG8_BAR; }
        if constexpr (!Epi::AFTER_DRAIN) E(acc, cur, wr, wc, fr, fq);
        if (!has_next) break;
#pragma unroll
        for (int a = 0; a < 2; ++a)
#pragma unroll
            for (int b = 0; b < 2; ++b)
#pragma unroll
                for (int m = 0; m < 4; ++m)
#pragma unroll
                    for (int n = 0; n < 2; ++n) acc[a][b][m][n] = (f32x4){0.f, 0.f, 0.f, 0.f};
        cur = nxt; cA = nA; cB = nB; ++ui;
        if constexpr (ALIGN_EPI) { if (wr == 1) PG8_BAR; }
    }
    PG8_WAIT_V(0);
    if constexpr (!ALIGN_EPI) { if (wr == 0) PG8_BAR; }
    PG8_BAR;
    if constexpr (Epi::AFTER_DRAIN) E.fused(acc, cur, wr, wc, fr, fq, lds, wid, lane);
#undef PG8_SA
#undef PG8_SB
#undef PG8_STAGE
#undef PG8_LDA
#undef PG8_LDB
#undef PG8_MMA
#undef PG8_WAIT_V
#undef PG8_WAIT_L
#undef PG8_BAR
#undef PG8_SCHED
#undef PG8_PTRS
}

DI void store_bf16_tile(const f32x4 (&acc)[2][2][4][2], u16* base, size_t ldc, int row0, int col0) {
#pragma unroll
    for (int ai = 0; ai < 2; ++ai)
#pragma unroll
        for (int m = 0; m < 4; ++m) { u16* rowp = base + (size_t)(row0 + ai * HALF + m * 16) * ldc + col0;
#pragma unroll
            for (int bj = 0; bj < 2; ++bj) { const f32x4 v0 = acc[ai][bj][m][0], v1 = acc[ai][bj][m][1];
                u32x4 w; w.x = pk2(v0[0], v0[1]); w.y = pk2(v0[2], v0[3]); w.z = pk2(v1[0], v1[1]); w.w = pk2(v1[2], v1[3]);
                *(u32x4*)(rowp + bj * HALF) = w; } }
}
struct EpiProj {
    static constexpr bool PERM = true, AFTER_DRAIN = false;
    u16* projn; float* loga; u16* projt; const float* b_a;
    DI void operator()(const f32x4 (&acc)[2][2][4][2], const Unit& u, int wr, int wc, int fr, int fq) const {
        if (u.pn < 9) store_bf16_tile(acc, projn, LDN, u.pm * BM + wr * 64 + fr, u.pn * BM + wc * 32 + 8 * fq);
        else if (u.pn >= 10) store_bf16_tile(acc, projt, MTOK, (u.pn - 10) * BM + wr * 64 + fr, u.pm * BM + wc * 32 + 8 * fq);
        else {
            const int row0 = u.pm * BM + wr * 64 + fr, col0 = wc * 32 + 8 * fq;
#pragma unroll
            for (int bj = 0; bj < 2; ++bj)
#pragma unroll
                for (int n = 0; n < 2; ++n) { const int col = col0 + bj * HALF + 4 * n; const f32x4 bv = *(const f32x4*)(b_a + col);
#pragma unroll
                    for (int ai = 0; ai < 2; ++ai)
#pragma unroll
                        for (int m = 0; m < 4; ++m) { const f32x4 v = acc[ai][bj][m][n] + bv; f32x4 o;
#pragma unroll
                            for (int j = 0; j < 4; ++j) o[j] = logsig_f(v[j]) * 0.0625f;
                            *(f32x4*)(loga + (size_t)(row0 + ai * HALF + m * 16) * 256 + col) = o; } }
        }
    }
};
struct EpiOut {
    static constexpr bool PERM = true, AFTER_DRAIN = false;
    u16* y;
    DI void operator()(const f32x4 (&acc)[2][2][4][2], const Unit& u, int wr, int wc, int fr, int fq) const {
        store_bf16_tile(acc, y, DM, u.pm * BM + wr * 64 + fr, u.pn * BM + wc * 32 + 8 * fq);
    }
};
}

DI void tr_item(const float* W, int ldw, int srccol0, float scale, u16* WT, int k0, LAS float* scr, int lane) {
#pragma unroll 8
    for (int i = 0; i < 32; ++i) { const int kk = 2 * i + (lane >> 5); scr[kk * 33 + (lane & 31)] = W[(size_t)(k0 + kk) * ldw + srccol0 + (lane & 31)]; }
    asm volatile("s_waitcnt lgkmcnt(0)" ::: "memory");
    const int c = lane & 7;
#pragma unroll
    for (int j = 0; j < 4; ++j) { const int n = (lane >> 3) + 8 * j; const LAS float* s = scr + (8 * c) * 33 + n;
        u32x4 o; o.x = pk2(s[0 * 33] * scale, s[1 * 33] * scale); o.y = pk2(s[2 * 33] * scale, s[3 * 33] * scale); o.z = pk2(s[4 * 33] * scale, s[5 * 33] * scale); o.w = pk2(s[6 * 33] * scale, s[7 * 33] * scale);
        *(u32x4*)(WT + (size_t)n * 1024 + k0 + 8 * c) = o; }
    asm volatile("s_waitcnt lgkmcnt(0)" ::: "memory");
}
DI bool bt_src(int n0, int& src, float& scale) {
    scale = 1.f;
    if (n0 < 256) { src = n0; scale = 0.125f; return true; }
    if (n0 < 512) { src = n0; return true; }
    if (n0 < 1024) { src = 1024 + (n0 - 512); return true; }
    if (n0 < 1280) { src = 1552 + (n0 - 1024); scale = 0.125f; return true; }
    if (n0 < 1536) { src = 1808 + (n0 - 1280); return true; }
    if (n0 < 1792) { src = 2320 + (n0 - 1536); return true; }
    if (n0 < 2048) { src = 2576 + (n0 - 1792); scale = 0.125f; return true; }
    if (n0 < 2304) { src = 2832 + (n0 - 2048); return true; }
    if (n0 < 2560) { src = 0; return false; }
    if (n0 < 2816) { src = 256 + (n0 - 2560); return true; }
    if (n0 < 3328) { src = 512 + (n0 - 2816); return true; }
    src = 2064 + (n0 - 3328); return true;
}
DI void prologue(const Params& p, LAS unsigned char* lds) {
    const int tid = otid(), lane = tid & 63, wave = tid >> 6;
    const int gw = blockIdx.x * 8 + wave, NGW = gridDim.x * 8;
    const size_t gt = (size_t)blockIdx.x * 512 + tid, NGT = (size_t)gridDim.x * 512;
    u16* bt = (u16*)(p.ws + WS_BT); u16* bo = (u16*)(p.ws + WS_BO);
    LAS float* scr = (LAS float*)(lds + wave * 8448);
    constexpr int I_IN = DEPTH * 112 * 16, I_OUT = DEPTH * 32 * 16;
    for (int it = gw; it < I_IN + I_OUT; it += NGW) {
        if (it < I_IN) { const int l = it / (112 * 16), r = it % (112 * 16), nb = r / 16, kb = r % 16; int src; float sc;
            if (bt_src(nb * 32, src, sc)) tr_item(p.w_in + (size_t)l * DM * DIN, DIN, src, sc, bt + ((size_t)l * NBT + nb * 32) * 1024, kb * 64, scr, lane); }
        else { const int r0 = it - I_IN, l = r0 / (32 * 16), r = r0 % (32 * 16), nb = r / 16, kb = r % 16;
            tr_item(p.w_out + (size_t)l * DM * DM, DM, nb * 32, 1.f, bo + ((size_t)l * 1024 + nb * 32) * 1024, kb * 64, scr, lane); }
    }
    for (size_t g = gt; g < (size_t)DEPTH * 256 * 128; g += NGT) {
        const int l = (int)(g >> 15), c = (int)(g >> 7) & 255, k = ((int)g & 127) * 8;
        float w2[16];
#pragma unroll
        for (int r = 0; r < 16; ++r) w2[r] = p.w_a2[((size_t)l * 16 + r) * 256 + c];
        float o[8];
#pragma unroll
        for (int kk = 0; kk < 8; ++kk) { const float* wr_ = p.w_in + ((size_t)l * DM + k + kk) * DIN + 1536; float a = 0.f;
#pragma unroll
            for (int r = 0; r < 16; r += 4) { const f32x4 v = *(const f32x4*)(wr_ + r); a += v[0] * w2[r] + v[1] * w2[r + 1] + v[2] * w2[r + 2] + v[3] * w2[r + 3]; }
            o[kk] = a; }
        u32x4 w; w.x = pk2(o[0], o[1]); w.y = pk2(o[2], o[3]); w.z = pk2(o[4], o[5]); w.w = pk2(o[6], o[7]);
        *(u32x4*)(bt + ((size_t)l * NBT + 2304 + c) * 1024 + k) = w;
    }
    { u16* xb = (u16*)(p.ws + WS_XB);
      for (size_t g = gt; g < (size_t)MTOK * DM / 8; g += 4 * NGT) { f32x4 a[4], b[4];
#pragma unroll
          for (int j = 0; j < 4; ++j) { a[j] = *(const f32x4*)(p.x + (g + j * NGT) * 8); b[j] = *(const f32x4*)(p.x + (g + j * NGT) * 8 + 4); }
#pragma unroll
          for (int j = 0; j < 4; ++j) { u32x4 w; w.x = pk2(a[j][0], a[j][1]); w.y = pk2(a[j][2], a[j][3]); w.z = pk2(b[j][0], b[j][1]); w.w = pk2(b[j][2], b[j][3]); *(u32x4*)(xb + (g + j * NGT) * 8) = w; } } }
    { u16* km = (u16*)(p.ws + WS_KM); u16* vmt = (u16*)(p.ws + WS_VMT); const int r = lane & 31, h = lane >> 5;
      for (int it = gw; it < DEPTH * NB * 8 * 16; it += NGW) {
          const int nt = it & 15, mt = (it >> 4) & 7, b = (it >> 7) & 1, l = it >> 8;
          const float* arow = p.mem + ((size_t)b * NMEM + mt * 32 + r) * DM + 8 * h;
          const float* bcol = p.w_mkv + (size_t)l * DM * 512 + (size_t)(8 * h) * 512 + nt * 32 + r;
          f32x16 acc = zero16();
#pragma unroll 4
          for (int s = 0; s < 64; ++s) {
              const f32x4 a0 = *(const f32x4*)(arow + 16 * s), a1 = *(const f32x4*)(arow + 16 * s + 4);
              float bv[8];
#pragma unroll
              for (int j = 0; j < 8; ++j) bv[j] = bcol[(size_t)(16 * s + j) * 512];
              acc = MFMA32(pack8(a0[0], a0[1], a0[2], a0[3], a1[0], a1[1], a1[2], a1[3]), pack8(bv[0], bv[1], bv[2], bv[3], bv[4], bv[5], bv[6], bv[7]), acc);
          }
          const int n = nt * 32 + r;
#pragma unroll
          for (int i = 0; i < 16; ++i) { const int m = mt * 32 + crow(i, h); const u16 v = (u16)(pk2(acc[i], 0.f) & 0xffffu);
              if (n < 256) km[((((size_t)l * NB + b) * 4 + (n >> 6)) * 256 + m) * 64 + (n & 63)] = v;
              else { const int n2 = n - 256; vmt[((((size_t)l * NB + b) * 4 + (n2 >> 6)) * 64 + (n2 & 63)) * 256 + m] = v; } }
      } }
}

DI void gla_cumsum(const float* loga, int chunk, LAS float* G) {
    const int tid = otid(), col = tid & 255, half = tid >> 8;
    const float* src = loga + ((size_t)chunk * 64 + 32 * half) * 256 + col;
    float v[32];
#pragma unroll
    for (int t = 0; t < 32; ++t) v[t] = src[(size_t)t * 256];
#pragma unroll
    for (int t = 1; t < 32; ++t) v[t] += v[t - 1];
    LAS float* tot = G + 64 * GS;
    if (half == 0) tot[col] = v[31];
    __syncthreads();
    const float off = half ? tot[col] : 0.f;
#pragma unroll
    for (int t = 0; t < 32; ++t) G[(32 * half + t) * GS + col] = v[t] + off;
}
DI void gla_u_wave(const Params& p, int chunk, int wave, int lane, const LAS float* G) {
    const int hh = wave >> 1, vh = wave & 1, r = lane & 31, h = lane >> 5;
    const u16* projt = (const u16*)(p.ws + WS_PT); float* U = (float*)(p.ws + WS_U); float* gd = (float*)(p.ws + WS_GD);
    const size_t tok0 = (size_t)chunk * 64;
    f32x16 acc[2][2];
#pragma unroll
    for (int a = 0; a < 2; ++a)
#pragma unroll
        for (int b = 0; b < 2; ++b) acc[a][b] = zero16();
    float glast[2];
#pragma unroll
    for (int cb = 0; cb < 2; ++cb) glast[cb] = G[63 * GS + hh * 64 + 32 * cb + r];
    bf16x8 af[4][2], ktf[4][2];
#pragma unroll
    for (int s = 0; s < 4; ++s) {
#pragma unroll
        for (int rb = 0; rb < 2; ++rb) af[s][rb] = ld_frag(projt + (size_t)(PT_GV + hh * 128 + 64 * vh + 32 * rb + r) * MTOK + tok0 + 16 * s + 8 * h);
#pragma unroll
        for (int cb = 0; cb < 2; ++cb) ktf[s][cb] = ld_frag(projt + (size_t)(PT_GK + hh * 64 + 32 * cb + r) * MTOK + tok0 + 16 * s + 8 * h);
    }
    __builtin_amdgcn_sched_barrier(0);
#pragma unroll
    for (int s = 0; s < 4; ++s) {
        bf16x8 bfr[2];
#pragma unroll
        for (int cb = 0; cb < 2; ++cb) { const int dk = 32 * cb + r; const bf16x8 kt = ktf[s][cb];
            float v[8];
#pragma unroll
            for (int j = 0; j < 8; ++j) { const int t = 16 * s + 8 * h + j; v[j] = bf2f(kt[j]) * __expf(glast[cb] - G[t * GS + hh * 64 + dk]); }
            bfr[cb] = pack8(v[0], v[1], v[2], v[3], v[4], v[5], v[6], v[7]); }
#pragma unroll
        for (int rb = 0; rb < 2; ++rb)
#pragma unroll
            for (int cb = 0; cb < 2; ++cb) acc[rb][cb] = MFMA32(af[s][rb], bfr[cb], acc[rb][cb]);
    }
    float* Ub = U + ((size_t)chunk * 4 + hh) * 8192;
#pragma unroll
    for (int rb = 0; rb < 2; ++rb)
#pragma unroll
        for (int cb = 0; cb < 2; ++cb)
#pragma unroll
            for (int i = 0; i < 16; ++i) Ub[(size_t)(64 * vh + 32 * rb + crow(i, h)) * 64 + 32 * cb + r] = acc[rb][cb][i];
    if (vh == 0) gd[((size_t)chunk * 4 + hh) * 64 + lane] = __expf(G[63 * GS + hh * 64 + lane]);
}
DI void sb_item(const Params& p, int item, int lane) {
    const int head = item & 3, tile = item >> 2, b = tile >> 9, tt = tile & 511, r = lane & 31, h = lane >> 5;
    const u16* projn = (const u16*)(p.ws + WS_PN); const u16* projt = (const u16*)(p.ws + WS_PT); u16* mix = (u16*)(p.ws + WS_MIX);
    const size_t tok0 = (size_t)b * SEQ + (size_t)tt * 32;
    bf16x8 qf[4];
    { const u16* qrow = projn + (tok0 + r) * LDN + PN_SQ + head * 64;
#pragma unroll
      for (int s = 0; s < 4; ++s) qf[s] = ld_frag(qrow + 16 * s + 8 * h); }
    bf16x8 tri[2];
#pragma unroll
    for (int s = 0; s < 2; ++s)
#pragma unroll
        for (int j = 0; j < 8; ++j) tri[s][j] = (16 * s + 8 * (j >> 2) + 4 * h + (j & 3) >= r) ? (short)0x3F80 : (short)0;
    const u16* vt0 = projt + (size_t)(PT_SV + head * 64 + r) * MTOK + (size_t)b * SEQ;
    const u16* vt1 = vt0 + (size_t)32 * MTOK;
    f32x16 o0 = zero16(), o1 = zero16();
    float R = 0.f;
    const int qpos = tt * 32 + r;
    const u16* kbase = projn + ((size_t)b * SEQ + r) * LDN + PN_SK + head * 64 + 8 * h;
    bf16x8 kf[4], va[2], vb[2];
#pragma unroll
    for (int s = 0; s < 4; ++s) kf[s] = ld_frag(kbase + (size_t)tt * 32 * LDN + 16 * s);
#pragma unroll
    for (int s = 0; s < 2; ++s) { va[s] = ld_frag_perm(vt0 + tt * 32 + 16 * s, h); vb[s] = ld_frag_perm(vt1 + tt * 32 + 16 * s, h); }
    for (int kb = tt;; --kb) {
        const int kn = kb > 0 ? kb - 1 : 0;
        bf16x8 nk[4], na[2], nb[2];
#pragma unroll
        for (int s = 0; s < 4; ++s) nk[s] = ld_frag(kbase + (size_t)kn * 32 * LDN + 16 * s);
#pragma unroll
        for (int s = 0; s < 2; ++s) { na[s] = ld_frag_perm(vt0 + kn * 32 + 16 * s, h); nb[s] = ld_frag_perm(vt1 + kn * 32 + 16 * s, h); }
        __builtin_amdgcn_sched_barrier(0);
        f32x16 z = zero16();
#pragma unroll
        for (int s = 0; s < 4; ++s) z = MFMA32(kf[s], qf[s], z);
        const bool diag = (kb == tt);
        f32x16 sp;
#pragma unroll
        for (int i = 0; i < 16; ++i) { const bool ok = !diag || (kb * 32 + crow(i, h) < qpos); sp[i] = ok ? softplus_f(z[i]) : 0.f; }
        f32x16 tm = zero16();
#pragma unroll
        for (int s = 0; s < 2; ++s) tm = MFMA32(tri[s], PACK_STEP(sp, s), tm);
        f32x16 pw;
#pragma unroll
        for (int i = 0; i < 16; ++i) { const bool ok = !diag || (kb * 32 + crow(i, h) < qpos); pw[i] = ok ? __expf(z[i] - tm[i] - R) : 0.f; }
#pragma unroll
        for (int s = 0; s < 2; ++s) { const bf16x8 pb = PACK_STEP(pw, s);
            o0 = MFMA32(va[s], pb, o0);
            o1 = MFMA32(vb[s], pb, o1); }
        R += __shfl(tm[0], r);
        if (kb == 0 || __all(R > SB_THR)) break;
#pragma unroll
        for (int s = 0; s < 4; ++s) kf[s] = nk[s];
#pragma unroll
        for (int s = 0; s < 2; ++s) { va[s] = na[s]; vb[s] = nb[s]; }
    }
    const u16* grow = projn + (tok0 + r) * LDN + PN_SG + head * 64;
    u16* mrow = mix + (tok0 + r) * DM + 512 + head * 64;
#pragma unroll
    for (int db = 0; db < 2; ++db)
#pragma unroll
        for (int g = 0; g < 4; ++g) { const int d = 32 * db + 8 * g + 4 * h; const s16x4 gv = *(const s16x4*)(grow + d);
            float o[4];
#pragma unroll
            for (int e = 0; e < 4; ++e) o[e] = (db ? o1[4 * g + e] : o0[4 * g + e]) * silu_f(bf2f(gv[e]));
            u32x2 w; w.x = pk2(o[0], o[1]); w.y = pk2(o[2], o[3]); *(u32x2*)(mrow + d) = w; }
}
DI void mem_item(const Params& p, int l, int item, int lane) {
    const int head = item & 3, tile = item >> 2, b = tile >> 9, tt = tile & 511, r = lane & 31, h = lane >> 5;
    const u16* projn = (const u16*)(p.ws + WS_PN); u16* mix = (u16*)(p.ws + WS_MIX);
    const u16* km = (const u16*)(p.ws + WS_KM) + (((size_t)l * NB + b) * 4 + head) * 256 * 64;
    const u16* vmt = (const u16*)(p.ws + WS_VMT) + (((size_t)l * NB + b) * 4 + head) * 64 * 256;
    const size_t tok0 = (size_t)b * SEQ + (size_t)tt * 32;
    bf16x8 qf[4];
    { const u16* qrow = projn + (tok0 + r) * LDN + PN_MQ + head * 64;
#pragma unroll
      for (int s = 0; s < 4; ++s) qf[s] = ld_frag(qrow + 16 * s + 8 * h); }
    const u16* kmr = km + (size_t)r * 64 + 8 * h;
    const u16* v0p = vmt + (size_t)r * 256; const u16* v1p = vmt + (size_t)(32 + r) * 256;
    bf16x8 kf[8][4], va[8][2], vb[8][2];
#define MEM_LOADB(mb) do { _Pragma("unroll") for (int s = 0; s < 4; ++s) kf[mb][s] = ld_frag(kmr + (size_t)(mb) * 32 * 64 + 16 * s); \
        _Pragma("unroll") for (int s = 0; s < 2; ++s) { va[mb][s] = ld_frag_perm(v0p + (mb) * 32 + 16 * s, h); vb[mb][s] = ld_frag_perm(v1p + (mb) * 32 + 16 * s, h); } } while (0)
    MEM_LOADB(0); MEM_LOADB(1);
    float mx = -3.0e38f, sum = 0.f;
    f32x16 o0 = zero16(), o1 = zero16();
#pragma unroll
    for (int mb = 0; mb < 8; ++mb) {
        if (mb + 2 < 8) MEM_LOADB((mb + 2 < 8 ? mb + 2 : 7));
        __builtin_amdgcn_sched_barrier(0);
        f32x16 z = zero16();
#pragma unroll
        for (int s = 0; s < 4; ++s) z = MFMA32(kf[mb][s], qf[s], z);
        float bm = z[0];
#pragma unroll
        for (int i = 1; i < 16; ++i) bm = fmaxf(bm, z[i]);
        bm = fmaxf(bm, __shfl_xor(bm, 32));
        const float mn = fmaxf(mx, bm), sc = __expf(mx - mn);
        mx = mn;
        f32x16 pw; float ps = 0.f;
#pragma unroll
        for (int i = 0; i < 16; ++i) { pw[i] = __expf(z[i] - mn); ps += pw[i]; }
        sum = sum * sc + ps;
#pragma unroll
        for (int i = 0; i < 16; ++i) { o0[i] *= sc; o1[i] *= sc; }
#pragma unroll
        for (int s = 0; s < 2; ++s) { const bf16x8 pb = PACK_STEP(pw, s);
            o0 = MFMA32(va[mb][s], pb, o0);
            o1 = MFMA32(vb[mb][s], pb, o1); }
    }
#undef MEM_LOADB
    sum += __shfl_xor(sum, 32);
    const float inv = 1.f / sum;
    const u16* grow = projn + (tok0 + r) * LDN + PN_MG + head * 64;
    u16* mrow = mix + (tok0 + r) * DM + 768 + head * 64;
#pragma unroll
    for (int db = 0; db < 2; ++db)
#pragma unroll
        for (int g = 0; g < 4; ++g) { const int d = 32 * db + 8 * g + 4 * h; const s16x4 gv = *(const s16x4*)(grow + d);
            float o[4];
#pragma unroll
            for (int e = 0; e < 4; ++e) o[e] = (db ? o1[4 * g + e] : o0[4 * g + e]) * inv * silu_f(bf2f(gv[e]));
            u32x2 w; w.x = pk2(o[0], o[1]); w.y = pk2(o[2], o[3]); *(u32x2*)(mrow + d) = w; }
}
DI void gla_scan(const Params& p) {
    const int tid = otid(); if (tid >= 256) return;
    const int e = blockIdx.x * 256 + tid; if (e >= 65536) return;
    const float* U = (const float*)(p.ws + WS_U); const float* gd = (const float*)(p.ws + WS_GD); u16* Sb = (u16*)(p.ws + WS_SB);
    const int bh = e >> 13, b = bh >> 2, hh = bh & 3, idx = e & 8191, dk = idx & 63;
    float s = 0.f;
    for (int n0 = 0; n0 < 256; n0 += 16) {
        float u[16], g[16];
#pragma unroll
        for (int j = 0; j < 16; ++j) { const size_t base = ((size_t)(b * 256 + n0 + j)) * 4 + hh; u[j] = U[base * 8192 + idx]; g[j] = gd[base * 64 + dk]; }
#pragma unroll
        for (int j = 0; j < 16; ++j) { const size_t base = ((size_t)(b * 256 + n0 + j)) * 4 + hh; Sb[base * 8192 + idx] = (u16)(pk2(s, 0.f) & 0xffffu); s = g[j] * s + u[j]; }
    }
}
DI void gla_out_wave(const Params& p, int l, int chunk, int wave, int lane, const LAS float* G) {
    const int hh = wave >> 1, ih = wave & 1, r = lane & 31, h = lane >> 5;
    const u16* projn = (const u16*)(p.ws + WS_PN); const u16* projt = (const u16*)(p.ws + WS_PT); u16* mix = (u16*)(p.ws + WS_MIX);
    const size_t tok0 = (size_t)chunk * 64;
    const int ti = 32 * ih + r;
    const u16* Sbf = (const u16*)(p.ws + WS_SB) + ((size_t)chunk * 4 + hh) * 8192;
    const u16* vrow = projt + (size_t)(PT_GV + hh * 128 + r) * MTOK + tok0;
    bf16x8 qr[4], kr[2][4], sf0[2][4], vf0[2][2][2];
    { const u16* qrow = projn + (tok0 + ti) * LDN + PN_GQ + hh * 64 + 8 * h;
#pragma unroll
      for (int s = 0; s < 4; ++s) qr[s] = ld_frag(qrow + 16 * s); }
#pragma unroll
    for (int jb = 0; jb < 2; ++jb)
#pragma unroll
        for (int s = 0; s < 4; ++s) kr[jb][s] = ld_frag(projn + (tok0 + 32 * jb + r) * LDN + PN_GK + hh * 64 + 16 * s + 8 * h);
#pragma unroll
    for (int rb = 0; rb < 2; ++rb) {
#pragma unroll
        for (int s = 0; s < 4; ++s) sf0[rb][s] = ld_frag(Sbf + (size_t)(32 * rb + r) * 64 + 16 * s + 8 * h);
#pragma unroll
        for (int jb = 0; jb < 2; ++jb)
#pragma unroll
            for (int s = 0; s < 2; ++s) vf0[rb][jb][s] = ld_frag_perm(vrow + (size_t)(32 * rb) * MTOK + 32 * jb + 16 * s, h);
    }
    __builtin_amdgcn_sched_barrier(0);
    bf16x8 qf[4];
#pragma unroll
    for (int s = 0; s < 4; ++s) { const bf16x8 q = qr[s]; const LAS float* gp = G + ti * GS + hh * 64 + 16 * s + 8 * h;
        const f32x4 g0 = *(const LAS f32x4*)gp, g1 = *(const LAS f32x4*)(gp + 4);
        qf[s] = pack8(bf2f(q[0]) * __expf(g0[0]), bf2f(q[1]) * __expf(g0[1]), bf2f(q[2]) * __expf(g0[2]), bf2f(q[3]) * __expf(g0[3]),
                      bf2f(q[4]) * __expf(g1[0]), bf2f(q[5]) * __expf(g1[1]), bf2f(q[6]) * __expf(g1[2]), bf2f(q[7]) * __expf(g1[3])); }
    bf16x8 pb[2][2];
#pragma unroll
    for (int jb = 0; jb < 2; ++jb) {
        f32x16 am = zero16();
        const int tj = 32 * jb + r;
#pragma unroll
        for (int s = 0; s < 4; ++s) { const bf16x8 k = kr[jb][s]; const LAS float* gp = G + tj * GS + hh * 64 + 16 * s + 8 * h;
            const f32x4 g0 = *(const LAS f32x4*)gp, g1 = *(const LAS f32x4*)(gp + 4);
            const bf16x8 kf = pack8(bf2f(k[0]) * __expf(-g0[0]), bf2f(k[1]) * __expf(-g0[1]), bf2f(k[2]) * __expf(-g0[2]), bf2f(k[3]) * __expf(-g0[3]),
                                    bf2f(k[4]) * __expf(-g1[0]), bf2f(k[5]) * __expf(-g1[1]), bf2f(k[6]) * __expf(-g1[2]), bf2f(k[7]) * __expf(-g1[3]));
            am = MFMA32(kf, qf[s], am); }
#pragma unroll
        for (int i = 0; i < 16; ++i) am[i] = (32 * jb + crow(i, h) <= ti) ? am[i] : 0.f;
#pragma unroll
        for (int s = 0; s < 2; ++s) pb[jb][s] = PACK_STEP(am, s);
    }
    bf16x8 sf1[2][4], vf1[2][2][2];
#pragma unroll
    for (int rb = 0; rb < 2; ++rb) {
#pragma unroll
        for (int s = 0; s < 4; ++s) sf1[rb][s] = ld_frag(Sbf + (size_t)(64 + 32 * rb + r) * 64 + 16 * s + 8 * h);
#pragma unroll
        for (int jb = 0; jb < 2; ++jb)
#pragma unroll
            for (int s = 0; s < 2; ++s) vf1[rb][jb][s] = ld_frag_perm(vrow + (size_t)(64 + 32 * rb) * MTOK + 32 * jb + 16 * s, h);
    }
    __builtin_amdgcn_sched_barrier(0);
    f32x16 o[4];
#pragma unroll
    for (int rb = 0; rb < 4; ++rb) o[rb] = zero16();
#pragma unroll
    for (int rb = 0; rb < 2; ++rb) {
#pragma unroll
        for (int s = 0; s < 4; ++s) o[rb] = MFMA32(sf0[rb][s], qf[s], o[rb]);
#pragma unroll
        for (int jb = 0; jb < 2; ++jb)
#pragma unroll
            for (int s = 0; s < 2; ++s) o[rb] = MFMA32(vf0[rb][jb][s], pb[jb][s], o[rb]);
    }
#pragma unroll
    for (int rb = 0; rb < 2; ++rb) {
#pragma unroll
        for (int s = 0; s < 4; ++s) o[2 + rb] = MFMA32(sf1[rb][s], qf[s], o[2 + rb]);
#pragma unroll
        for (int jb = 0; jb < 2; ++jb)
#pragma unroll
            for (int s = 0; s < 2; ++s) o[2 + rb] = MFMA32(vf1[rb][jb][s], pb[jb][s], o[2 + rb]);
    }
    float ss = 0.f;
#pragma unroll
    for (int rb = 0; rb < 4; ++rb)
#pragma unroll
        for (int i = 0; i < 16; ++i) ss += o[rb][i] * o[rb][i];
    ss += __shfl_xor(ss, 32);
    const float rinv = rsqrtf(ss * (1.f / 128.f) + RMS_EPS);
    const u16* grow = projn + (tok0 + ti) * LDN + PN_GG + hh * 128;
    u16* mrow = mix + (tok0 + ti) * DM + hh * 128;
    const float* nw = p.gnw + (size_t)l * 128;
#pragma unroll
    for (int rb = 0; rb < 4; ++rb)
#pragma unroll
        for (int g = 0; g < 4; ++g) { const int dv = 32 * rb + 8 * g + 4 * h; const s16x4 gv = *(const s16x4*)(grow + dv); const f32x4 wv = *(const f32x4*)(nw + dv);
            float ov[4];
#pragma unroll
            for (int e = 0; e < 4; ++e) ov[e] = o[rb][4 * g + e] * rinv * wv[e] * silu_f(bf2f(gv[e]));
            u32x2 w; w.x = pk2(ov[0], ov[1]); w.y = pk2(ov[2], ov[3]); *(u32x2*)(mrow + dv) = w; }
}
DI void ln_phase(const Params& p, int l) {
    const int tid = otid(), lane = tid & 63, gw = blockIdx.x * 8 + (tid >> 6), NGW = gridDim.x * 8;
    const float* xin = l == 0 ? p.x : p.out; const u16* y = (const u16*)(p.ws + WS_PN); u16* xb = (u16*)(p.ws + WS_XB);
    const float* gam = p.ln_g + (size_t)l * DM; const float* bet = p.ln_b + (size_t)l * DM;
    for (int row = gw; row < MTOK; row += NGW) {
        f32x4 v[4]; float s = 0.f;
#pragma unroll
        for (int j = 0; j < 4; ++j) { const int c = 4 * lane + 256 * j; const f32x4 xv = *(const f32x4*)(xin + (size_t)row * DM + c); const s16x4 yv = *(const s16x4*)(y + (size_t)row * DM + c);
#pragma unroll
            for (int e = 0; e < 4; ++e) { v[j][e] = ALPHA_DN * xv[e] + bf2f(yv[e]); s += v[j][e]; } }
#pragma unroll
        for (int o = 1; o < 64; o <<= 1) s += __shfl_xor(s, o);
        const float mean = s * (1.f / DM); float q = 0.f;
#pragma unroll
        for (int j = 0; j < 4; ++j)
#pragma unroll
            for (int e = 0; e < 4; ++e) { v[j][e] -= mean; q += v[j][e] * v[j][e]; }
#pragma unroll
        for (int o = 1; o < 64; o <<= 1) q += __shfl_xor(q, o);
        const float rstd = rsqrtf(q * (1.f / DM) + LN_EPS);
#pragma unroll
        for (int j = 0; j < 4; ++j) { const int c = 4 * lane + 256 * j; const f32x4 gv = *(const f32x4*)(gam + c), bv = *(const f32x4*)(bet + c); f32x4 ov;
#pragma unroll
            for (int e = 0; e < 4; ++e) ov[e] = v[j][e] * rstd * gv[e] + bv[e];
            *(f32x4*)(p.out + (size_t)row * DM + c) = ov;
            u32x2 w; w.x = pk2(ov[0], ov[1]); w.y = pk2(ov[2], ov[3]); *(u32x2*)(xb + (size_t)row * DM + c) = w; }
    }
}

#define XB_TMO      128
#define XB_XCNT(j)  (256  + 64 * (j))
#define XB_XSUB(j)  (1280 + 64 * (j))
#define XB_XGEN(j)  (2304 + 64 * (j))
#define XB_TOP      3328
#define XB_TOPGEN   3392
#define XCD_BAR_WORDS 3456
#define XB_SPIN_CAP (1u << 18)
DI unsigned xb_ld(unsigned* p)              { return __hip_atomic_load(p, __ATOMIC_RELAXED, __HIP_MEMORY_SCOPE_AGENT); }
DI unsigned xb_add(unsigned* p, unsigned v) { return __hip_atomic_fetch_add(p, v, __ATOMIC_RELAXED, __HIP_MEMORY_SCOPE_AGENT); }
DI unsigned xb_xcc_id() { return (unsigned)__builtin_amdgcn_s_getreg((3 << 11) | 20) & 0xFu; }
#define XB_SPIN(cond, bar) do { unsigned _sp = 0; while (cond) { __builtin_amdgcn_s_sleep(1); \
    if ((++_sp & 255u) == 0u) { if (xb_ld(&(bar)[XB_TMO])) break; if (_sp > XB_SPIN_CAP) { atomicAdd(&(bar)[XB_TMO], 1u); break; } } } } while (0)
struct XcdBarrier { unsigned* bar; unsigned x; volatile LAS unsigned* st; };
DI XcdBarrier xcd_barrier_post(unsigned* bar, volatile LAS unsigned* st) {
    XcdBarrier b; b.bar = bar; b.x = xb_xcc_id(); b.st = st;
    if (threadIdx.x == 0) (void)xb_add(&bar[XB_XCNT(b.x)], 1u);
    return b;
}
DI void xcd_barrier_complete(unsigned* bar, unsigned x, unsigned& nloc, unsigned& nx) {
    const unsigned G = gridDim.x * gridDim.y * gridDim.z;
    unsigned sum, cnt, mine, sp = 0u;
    for (;;) {
        sum = 0u; cnt = 0u; mine = 0u;
#pragma unroll
        for (unsigned j = 0; j < 16; ++j) { const unsigned c = xb_ld(&bar[XB_XCNT(j)]); sum += c; cnt += (c > 0u) ? 1u : 0u; mine = (j == x) ? c : mine; }
        if (sum == G) break;
        __builtin_amdgcn_s_sleep(1);
        if ((++sp & 255u) == 0u) { if (xb_ld(&bar[XB_TMO])) break; if (sp > XB_SPIN_CAP) { atomicAdd(&bar[XB_TMO], 1u); break; } }
    }
    nloc = mine > 0u ? mine : 1u; nx = cnt > 0u ? cnt : 1u;
}
DI void xcd_barrier(const XcdBarrier& b) {
    asm volatile("s_waitcnt vmcnt(0)" ::: "memory");
    __syncthreads();
    if (threadIdx.x == 0) {
        unsigned* bar = b.bar;
        __builtin_amdgcn_s_waitcnt(0);
        unsigned nloc = b.st[0], nx = b.st[1];
        if (nloc == 0u) { xcd_barrier_complete(bar, b.x, nloc, nx); b.st[0] = nloc; b.st[1] = nx; }
        const unsigned old = xb_add(&bar[XB_XSUB(b.x)], 1u);
        const unsigned gen = old / nloc;
        if (old + 1u == (gen + 1u) * nloc) {
            __builtin_amdgcn_fence(__ATOMIC_RELEASE, "agent");
            asm volatile("s_waitcnt vmcnt(0)" ::: "memory");
            const unsigned og = xb_add(&bar[XB_TOP], 1u);
            const unsigned tg = og / nx;
            if (og + 1u == (tg + 1u) * nx) xb_add(&bar[XB_TOPGEN], 1u);
            else XB_SPIN(xb_ld(&bar[XB_TOPGEN]) == tg, bar);
            __builtin_amdgcn_fence(__ATOMIC_ACQUIRE, "agent");
            xb_add(&bar[XB_XGEN(b.x)], 1u);
            asm volatile("s_waitcnt vmcnt(0)" ::: "memory");
        } else {
            XB_SPIN(xb_ld(&bar[XB_XGEN(b.x)]) == gen, bar);
            __builtin_amdgcn_fence(__ATOMIC_ACQUIRE, "agent");
            asm volatile("s_waitcnt vmcnt(0)" ::: "memory");
        }
    }
    __syncthreads();
}

__global__ __launch_bounds__(512, 2) void fwd_megakernel(Params p) {
    extern __shared__ __attribute__((aligned(16))) unsigned char shm[];
    cg::grid_group grid = cg::this_grid();
    LAS unsigned char* lds = (LAS unsigned char*)shm;
    volatile LAS unsigned* xbw = (volatile LAS unsigned*)(lds + 131072);
    if (threadIdx.x == 0) { xbw[0] = 0u; xbw[1] = 0u; }
    __syncthreads();
    const XcdBarrier xb = xcd_barrier_post((unsigned*)(p.ws + WS_BAR), xbw);
#pragma unroll 1
    for (int rep = 0; rep < REP_P; ++rep) prologue(p, lds);
    grid.sync();
#pragma unroll 1
    for (int l = 0; l < DEPTH; ++l) {
#pragma unroll 1
        for (int rep = 0; rep < REP_A; ++rep)
        { pg8::Gemm g{(const u16*)(p.ws + WS_XB), (const u16*)(p.ws + WS_BT) + (size_t)l * NBT * 1024, MTOK, NBT, DM, 10};
          pg8::StaticOrder S; S.init(MTOK, NBT, (int)gridDim.x, (int)blockIdx.x);
          pg8::EpiProj E{(u16*)(p.ws + WS_PN), (float*)(p.ws + WS_LA), (u16*)(p.ws + WS_PT), p.b_a + (size_t)l * 256};
          pg8::gemm_phase<pg8::EpiProj, true, true>(lds, g, S, E); }
        xcd_barrier(xb);
#pragma unroll 1
        for (int rep = 0; rep < EXTRA_SYNC; ++rep) xcd_barrier(xb);
#pragma unroll 1
        for (int rep = 0; rep < REP_B1; ++rep)
        { const int tid = otid(), lane = tid & 63, wave = tid >> 6;
          for (int c = blockIdx.x; c < 512; c += gridDim.x) {
            gla_cumsum((const float*)(p.ws + WS_LA), c, (LAS float*)lds);
            __syncthreads();
            gla_u_wave(p, c, wave, lane, (const LAS float*)lds);
            __syncthreads();
          } }
#pragma unroll 1
        for (int rep = 0; rep < REP_B2; ++rep)
        { const int tid = otid(), lane = tid & 63, gw = blockIdx.x * 8 + (tid >> 6), NGW = gridDim.x * 8;
          for (int it = gw; it < 4096; it += NGW) sb_item(p, it, lane); }
#pragma unroll 1
        for (int rep = 0; rep < REP_B3; ++rep)
        { const int tid = otid(), lane = tid & 63, gw = blockIdx.x * 8 + (tid >> 6), NGW = gridDim.x * 8;
          for (int it = gw; it < 4096; it += NGW) mem_item(p, l, it, lane); }
        xcd_barrier(xb);
#pragma unroll 1
        for (int rep = 0; rep < REP_C; ++rep) gla_scan(p);
        xcd_barrier(xb);
#pragma unroll 1
        for (int rep = 0; rep < REP_D; ++rep)
        { const int tid = otid(), lane = tid & 63, wave = tid >> 6;
          for (int c = blockIdx.x; c < 512; c += gridDim.x) {
            gla_cumsum((const float*)(p.ws + WS_LA), c, (LAS float*)lds);
            __syncthreads();
            gla_out_wave(p, l, c, wave, lane, (const LAS float*)lds);
            __syncthreads();
          } }
        xcd_barrier(xb);
#pragma unroll 1
        for (int rep = 0; rep < REP_E; ++rep)
        { pg8::Gemm g{(const u16*)(p.ws + WS_MIX), (const u16*)(p.ws + WS_BO) + (size_t)l * 1024 * 1024, MTOK, DM, DM, 1 << 30};
          pg8::StaticOrder S; S.init(MTOK, DM, (int)gridDim.x, (int)blockIdx.x);
          pg8::EpiOut E{(u16*)(p.ws + WS_PN)};
          pg8::gemm_phase<pg8::EpiOut, true, true>(lds, g, S, E); }
        xcd_barrier(xb);
        ln_phase(p, l);
        xcd_barrier(xb);
    }
}

extern "C" void kernel_launch(void* const* d_in, const int* in_sizes, int n_in, void* d_out, int out_size, void* d_ws, size_t ws_size, hipStream_t stream) {
    static int grid = 0;
    if (grid == 0) {
        if (n_in != 10 || in_sizes[0] != MTOK * DM || out_size != MTOK * DM || ws_size < WS_END) {
            fprintf(stderr, "kernel_launch: unexpected shapes or workspace (n_in %d, ws %zu, need %zu)\n", n_in, ws_size, (size_t)WS_END); grid = -1; return; }
        int dev = 0, cus = 0, per_cu = 0;
        (void)hipGetDevice(&dev);
        (void)hipDeviceGetAttribute(&cus, hipDeviceAttributeMultiprocessorCount, dev);
        if (hipFuncSetAttribute((const void*)fwd_megakernel, hipFuncAttributeMaxDynamicSharedMemorySize, LDS_BYTES) != hipSuccess) { fprintf(stderr, "kernel_launch: hipFuncSetAttribute failed\n"); grid = -1; return; }
        (void)hipOccupancyMaxActiveBlocksPerMultiprocessor(&per_cu, (const void*)fwd_megakernel, 512, LDS_BYTES);
        if (per_cu < 1) { fprintf(stderr, "kernel_launch: occupancy query says %d blocks per CU\n", per_cu); per_cu = 1; }
        (void)hipGetLastError();
        grid = cus;
    }
    if (grid < 0) return;
    if (hipMemsetAsync((unsigned char*)d_ws + WS_BAR, 0, 16384, stream) != hipSuccess) { fprintf(stderr, "kernel_launch: hipMemsetAsync failed\n"); return; }
    Params p{};
    p.x = (const float*)d_in[0]; p.mem = (const float*)d_in[1]; p.w_in = (const float*)d_in[2]; p.w_a2 = (const float*)d_in[3]; p.b_a = (const float*)d_in[4];
    p.gnw = (const float*)d_in[5]; p.w_mkv = (const float*)d_in[6]; p.w_out = (const float*)d_in[7]; p.ln_g = (const float*)d_in[8]; p.ln_b = (const float*)d_in[9];
    p.out = (float*)d_out; p.ws = (unsigned char*)d_ws;
    void* args[] = {&p};
    hipError_t e = hipLaunchCooperativeKernel((const void*)fwd_megakernel, dim3(grid), dim3(512), args, LDS_BYTES, stream);
    if (e != hipSuccess) fprintf(stderr, "cooperative launch failed: %s (grid %d)\n", hipGetErrorString(e), grid);
}
```
